# Optimizing an MI355X kernel written in HIP

```python
import math
import jax, jax.numpy as jnp
from jax import lax
import numpy as np

D_MODEL = 1024
BATCH = 32
SEQ = 256
DEPTH = 4
DEC_BATCH = 8
DEC_SEQ = 1024
PAST_LEN = 512

GRID_W = 64
N_MIXERS = 3
LAYER_KINDS = ('A', 'B', 'C', 'A')
A_HEADS = 16
A_KV_HEADS = 4
A_HEAD_DIM = 64
A_GROUP = A_HEADS // A_KV_HEADS
WINDOW = 128
C_HEADS = 8
C_KV_HEADS = 4
C_HEAD_DIM = 128
C_GROUP = C_HEADS // C_KV_HEADS
Q_BLOCK = 128
S5_GROUP = 16
S5_GROUPS = D_MODEL // S5_GROUP
S5_STATE = 64
DT_MIN = 1e-3
DT_MAX = 1e-1
D_FF = 2816
CONV_W = 3
ROPE_THETA = 10000.0
EPS = 1e-6

kernel_name = 'hybrid_diffusion_step'


def rms_norm(x, gain):
    xf = x.astype(jnp.float32)
    y = xf * lax.rsqrt(jnp.mean(xf * xf, axis=-1, keepdims=True) + EPS)
    return (y * gain.astype(jnp.float32)).astype(x.dtype)


def ada_params(cond, w_mod, b_mod):
    m = jax.nn.silu(cond) @ w_mod + b_mod
    return jnp.split(m[..., None, :], 6, axis=-1)


def sublayer_in(x, gain, shift, scale):
    return rms_norm(x, gain) * (1 + scale) + shift


def grid_positions(n_tokens):
    rows = n_tokens // GRID_W
    row = jnp.repeat(jnp.arange(rows), GRID_W)
    col = jnp.tile(jnp.arange(GRID_W), rows)
    return row, col


def axial_rope(x, row, col):
    dh = x.shape[-1]
    half = dh // 2
    quarter = half // 2
    freqs = 1.0 / (ROPE_THETA ** (jnp.arange(quarter, dtype=jnp.float32) / quarter))

    def rot(xa, pos):
        ang = pos.astype(jnp.float32)[:, None] * freqs[None, :]
        cos = jnp.cos(ang)[None, :, None, :].astype(x.dtype)
        sin = jnp.sin(ang)[None, :, None, :].astype(x.dtype)
        x1, x2 = xa[..., :quarter], xa[..., quarter:]
        return jnp.concatenate([x1 * cos - x2 * sin, x1 * sin + x2 * cos], axis=-1)

    return jnp.concatenate([rot(x[..., :half], row), rot(x[..., half:], col)], axis=-1)


def qkv_heads(x, p, n_heads, n_kv, dh):
    b, s, _ = x.shape
    qkv = x @ p['w_qkv']
    q = qkv[..., :n_heads * dh].reshape(b, s, n_heads, dh)
    k = qkv[..., n_heads * dh:(n_heads + n_kv) * dh].reshape(b, s, n_kv, dh)
    v = qkv[..., (n_heads + n_kv) * dh:].reshape(b, s, n_kv, dh)
    return rms_norm(q, p['q_norm']), rms_norm(k, p['k_norm']), v


def attend_block(q, k, v, valid, sink):
    scale = q.shape[-1] ** -0.5
    s = jnp.einsum('bqkgd,bskd->bkgqs', q, k, preferred_element_type=jnp.float32) * scale
    if valid is not None:
        s = jnp.where(valid, s, -jnp.inf)
    if sink is not None:
        sk = jnp.broadcast_to(sink.astype(jnp.float32)[None, :, :, None, None], s.shape[:-1] + (1,))
        probs = jax.nn.softmax(jnp.concatenate([s, sk], axis=-1), axis=-1)[..., :-1]
    else:
        probs = jax.nn.softmax(s, axis=-1)
    return jnp.einsum('bkgqs,bskd->bqkgd', probs.astype(v.dtype), v)


def sweep_query_blocks(q, block_fn):
    b, s = q.shape[:2]
    nb = s // Q_BLOCK
    qb = q.reshape((b, nb, Q_BLOCK) + q.shape[2:]).swapaxes(0, 1)
    out = lax.map(lambda args: block_fn(args[0], args[1]), (qb, jnp.arange(nb)))
    return out.swapaxes(0, 1).reshape(q.shape)


def attn_context(x, p, n_heads, n_kv, dh, sink):
    b, s, _ = x.shape
    q, k, v = qkv_heads(x, p, n_heads, n_kv, dh)
    qg = q.reshape(b, s, n_kv, n_heads // n_kv, dh)
    o = sweep_query_blocks(qg, lambda qb, i: attend_block(qb, k, v, None, sink))
    return o.reshape(b, s, n_heads * dh) @ p['w_o'], (k, v)


def window_attn_latent(x, p, ck, cv, row, col):
    b, s, _ = x.shape
    n_ctx = ck.shape[1]
    q, k, v = qkv_heads(x, p, A_HEADS, A_KV_HEADS, A_HEAD_DIM)
    q = axial_rope(q, row, col)
    k = axial_rope(k, row, col)
    qg = q.reshape(b, s, A_KV_HEADS, A_GROUP, A_HEAD_DIM)
    pad = ((0, 0), (WINDOW, WINDOW), (0, 0), (0, 0))
    kp = jnp.pad(k, pad)
    vp = jnp.pad(v, pad)
    band = Q_BLOCK + 2 * WINDOW
    sink = p['sink'].reshape(A_KV_HEADS, A_GROUP)
    ctx_valid = jnp.ones((Q_BLOCK, n_ctx), dtype=bool)

    def block(qb, i):
        start = i * Q_BLOCK
        kb = lax.dynamic_slice_in_dim(kp, start, band, axis=1)
        vb = lax.dynamic_slice_in_dim(vp, start, band, axis=1)
        qpos = start + jnp.arange(Q_BLOCK)
        kpos = start - WINDOW + jnp.arange(band)
        band_valid = ((jnp.abs(qpos[:, None] - kpos[None, :]) <= WINDOW)
                      & (kpos[None, :] >= 0) & (kpos[None, :] < s))
        valid = jnp.concatenate([ctx_valid, band_valid], axis=1)
        return attend_block(qb, jnp.concatenate([ck, kb], axis=1),
                            jnp.concatenate([cv, vb], axis=1), valid, sink)

    o = sweep_query_blocks(qg, block)
    return o.reshape(b, s, A_HEADS * A_HEAD_DIM) @ p['w_o']


def full_attn_latent(x, p, ck, cv, row, col):
    b, s, _ = x.shape
    q, k, v = qkv_heads(x, p, C_HEADS, C_KV_HEADS, C_HEAD_DIM)
    q = axial_rope(q, row, col)
    k = axial_rope(k, row, col)
    qg = q.reshape(b, s, C_KV_HEADS, C_GROUP, C_HEAD_DIM)
    k_all = jnp.concatenate([ck, k], axis=1)
    v_all = jnp.concatenate([cv, v], axis=1)
    o = sweep_query_blocks(qg, lambda qb, i: attend_block(qb, k_all, v_all, None, None))
    return o.reshape(b, s, C_HEADS * C_HEAD_DIM) @ p['w_o']


def s5_discretize(lam_re, lam_im, log_dt, b_re, b_im):
    lam_re = lam_re.astype(jnp.float32)
    lam_im = lam_im.astype(jnp.float32)
    dt = jnp.exp(log_dt.astype(jnp.float32))[:, None]
    mag = jnp.exp(lam_re * dt)
    a_re = mag * jnp.cos(lam_im * dt)
    a_im = mag * jnp.sin(lam_im * dt)
    den = lam_re * lam_re + lam_im * lam_im
    n_re = a_re - 1.0
    f_re = (n_re * lam_re + a_im * lam_im) / den
    f_im = (a_im * lam_re - n_re * lam_im) / den
    b_re = b_re.astype(jnp.float32)
    b_im = b_im.astype(jnp.float32)
    bb_re = f_re[..., None] * b_re - f_im[..., None] * b_im
    bb_im = f_re[..., None] * b_im + f_im[..., None] * b_re
    return a_re, a_im, bb_re, bb_im


def complex_scan(a_re, a_im, b_re, b_im, reverse):
    def combine(e1, e2):
        a1r, a1i, b1r, b1i = e1
        a2r, a2i, b2r, b2i = e2
        return (a2r * a1r - a2i * a1i, a2r * a1i + a2i * a1r,
                a2r * b1r - a2i * b1i + b2r, a2r * b1i + a2i * b1r + b2i)
    ar = jnp.broadcast_to(a_re, b_re.shape)
    ai = jnp.broadcast_to(a_im, b_re.shape)
    _, _, hr, hi = lax.associative_scan(combine, (ar, ai, b_re, b_im), reverse=reverse, axis=1)
    return hr, hi


def s5_mixer(u, p, s0):
    b, s, d = u.shape
    uf = u.astype(jnp.float32)
    ug = uf.reshape(b, s, S5_GROUPS, S5_GROUP)
    y = uf * p['d_skip'].astype(jnp.float32)
    finals = []
    for direction, reverse in ((0, False), (1, True)):
        a_re, a_im, bb_re, bb_im = s5_discretize(p['lam_re'][direction], p['lam_im'][direction],
                                                 p['log_dt'][direction], p['b_re'][direction],
                                                 p['b_im'][direction])
        br = jnp.einsum('bsgc,gpc->bsgp', ug, bb_re)
        bi = jnp.einsum('bsgc,gpc->bsgp', ug, bb_im)
        if s0 is not None:
            first = -1 if reverse else 0
            s_re = s0[:, direction, 0].astype(jnp.float32)
            s_im = s0[:, direction, 1].astype(jnp.float32)
            br = br.at[:, first].add(a_re * s_re - a_im * s_im)
            bi = bi.at[:, first].add(a_re * s_im + a_im * s_re)
        hr, hi = complex_scan(a_re, a_im, br, bi, reverse)
        c_re = p['c_re'][direction].astype(jnp.float32)
        c_im = p['c_im'][direction].astype(jnp.float32)
        y_dir = jnp.einsum('bsgp,gcp->bsgc', hr, c_re) - jnp.einsum('bsgp,gcp->bsgc', hi, c_im)
        y = y + y_dir.reshape(b, s, d)
        if s0 is None:
            last = 0 if reverse else -1
            finals.append(jnp.stack([hr[:, last], hi[:, last]], axis=1))
    g = jax.nn.gelu(y)
    h = g @ p['w_glu'].astype(jnp.float32)
    out = (h[..., :d] * jax.nn.sigmoid(h[..., d:])).astype(u.dtype)
    state = jnp.stack(finals, axis=1).astype(u.dtype) if s0 is None else None
    return out, state


def conv_ffn(x, w_up, b_up, conv_k, conv_b, w_down):
    s = x.shape[1]
    h = x @ w_up + b_up
    r = CONV_W // 2
    hp = jnp.pad(h, ((0, 0), (r, r), (0, 0)))
    h = conv_b + sum(hp[:, j:j + s] * conv_k[j] for j in range(CONV_W))
    gate, val = jnp.split(h, 2, axis=-1)
    return (jax.nn.silu(gate) * val) @ w_down


def context_mixer(kind, p, h):
    if kind == 'A':
        return attn_context(h, p, A_HEADS, A_KV_HEADS, A_HEAD_DIM,
                            p['sink'].reshape(A_KV_HEADS, A_GROUP))
    if kind == 'B':
        return s5_mixer(h, p, None)
    return attn_context(h, p, C_HEADS, C_KV_HEADS, C_HEAD_DIM, None)


def latent_mixer(kind, p, h, cache, row, col):
    if kind == 'A':
        return window_attn_latent(h, p, cache[0], cache[1], row, col)
    if kind == 'B':
        return s5_mixer(h, p, cache)[0]
    return full_attn_latent(h, p, cache[0], cache[1], row, col)


def setup_inputs(seed: int = 0) -> dict:
    key = jax.random.key(seed)
    keys = iter(jax.random.split(key, 64))

    def nrm(shape, scale):
        return scale * jax.random.normal(next(keys), shape, jnp.float32)

    def gain(shape):
        return 1.0 + nrm(shape, 0.02)

    D = D_MODEL
    a_qkv = (A_HEADS + 2 * A_KV_HEADS) * A_HEAD_DIM
    c_qkv = (C_HEADS + 2 * C_KV_HEADS) * C_HEAD_DIM

    def s5_lam_im():
        base = jnp.broadcast_to(jnp.pi * jnp.arange(S5_STATE, dtype=jnp.float32), (2, S5_GROUPS, S5_STATE))
        return base + nrm((2, S5_GROUPS, S5_STATE), 0.01)

    inputs = {
        'x_prompt': nrm((BATCH, SEQ, D), 1.0),
        'x_sample': nrm((DEC_BATCH, DEC_SEQ, D), 1.0),
        'cache_l0_k': nrm((DEC_BATCH, PAST_LEN, A_KV_HEADS, A_HEAD_DIM), 1.0),
        'cache_l0_v': nrm((DEC_BATCH, PAST_LEN, A_KV_HEADS, A_HEAD_DIM), 1.0),
        'state_l1': nrm((DEC_BATCH, 2, 2, S5_GROUPS, S5_STATE), 0.3),
        'cache_l2_k': nrm((DEC_BATCH, PAST_LEN, C_KV_HEADS, C_HEAD_DIM), 1.0),
        'cache_l2_v': nrm((DEC_BATCH, PAST_LEN, C_KV_HEADS, C_HEAD_DIM), 1.0),
        'cache_l3_k': nrm((DEC_BATCH, PAST_LEN, A_KV_HEADS, A_HEAD_DIM), 1.0),
        'cache_l3_v': nrm((DEC_BATCH, PAST_LEN, A_KV_HEADS, A_HEAD_DIM), 1.0),
        'c': nrm((DEC_BATCH, D), 1.0),
        'c_ctx': nrm((D,), 1.0),
        'norm1': gain((DEPTH, D)),
        'norm2': gain((DEPTH, D)),
        'w_mod': nrm((DEPTH, D, 6 * D), 0.5 * D ** -0.5),
        'b_mod': nrm((DEPTH, 6 * D), 0.02),
        'w_up': nrm((DEPTH, D, 2 * D_FF), D ** -0.5),
        'b_up': nrm((DEPTH, 2 * D_FF), 0.02),
        'conv_k': nrm((DEPTH, CONV_W, 2 * D_FF), CONV_W ** -0.5),
        'conv_b': nrm((DEPTH, 2 * D_FF), 0.02),
        'w_down': nrm((DEPTH, D_FF, D), D_FF ** -0.5),
        'l0_w_qkv': nrm((D, a_qkv), D ** -0.5),
        'l0_q_norm': gain((A_HEAD_DIM,)),
        'l0_k_norm': gain((A_HEAD_DIM,)),
        'l0_sink': nrm((A_HEADS,), 1.0),
        'l0_w_o': nrm((A_HEADS * A_HEAD_DIM, D), (A_HEADS * A_HEAD_DIM) ** -0.5),
        'l1_lam_re': -0.5 + nrm((2, S5_GROUPS, S5_STATE), 0.01),
        'l1_lam_im': s5_lam_im(),
        'l1_log_dt': jax.random.uniform(next(keys), (2, S5_GROUPS), jnp.float32,
                                        math.log(DT_MIN), math.log(DT_MAX)),
        'l1_b_re': nrm((2, S5_GROUPS, S5_STATE, S5_GROUP), (2 * S5_GROUP) ** -0.5),
        'l1_b_im': nrm((2, S5_GROUPS, S5_STATE, S5_GROUP), (2 * S5_GROUP) ** -0.5),
        'l1_c_re': nrm((2, S5_GROUPS, S5_GROUP, S5_STATE), (2 * S5_STATE) ** -0.5),
        'l1_c_im': nrm((2, S5_GROUPS, S5_GROUP, S5_STATE), (2 * S5_STATE) ** -0.5),
        'l1_d_skip': nrm((D,), 1.0),
        'l1_w_glu': nrm((D, 2 * D), D ** -0.5),
        'l2_w_qkv': nrm((D, c_qkv), D ** -0.5),
        'l2_q_norm': gain((C_HEAD_DIM,)),
        'l2_k_norm': gain((C_HEAD_DIM,)),
        'l2_w_o': nrm((C_HEADS * C_HEAD_DIM, D), (C_HEADS * C_HEAD_DIM) ** -0.5),
        'l3_w_qkv': nrm((D, a_qkv), D ** -0.5),
        'l3_q_norm': gain((A_HEAD_DIM,)),
        'l3_k_norm': gain((A_HEAD_DIM,)),
        'l3_sink': nrm((A_HEADS,), 1.0),
        'l3_w_o': nrm((A_HEADS * A_HEAD_DIM, D), (A_HEADS * A_HEAD_DIM) ** -0.5),
    }
    return inputs


def reference(x_prompt, x_sample, cache_l0_k, cache_l0_v, state_l1, cache_l2_k, cache_l2_v,
              cache_l3_k, cache_l3_v, c, c_ctx, norm1, norm2, w_mod, b_mod, w_up, b_up, conv_k,
              conv_b, w_down, l0_w_qkv, l0_q_norm, l0_k_norm, l0_sink, l0_w_o, l1_lam_re, l1_lam_im,
              l1_log_dt, l1_b_re, l1_b_im, l1_c_re, l1_c_im, l1_d_skip, l1_w_glu, l2_w_qkv,
              l2_q_norm, l2_k_norm, l2_w_o, l3_w_qkv, l3_q_norm, l3_k_norm, l3_sink, l3_w_o):
    mixer_params = (
        {'w_qkv': l0_w_qkv, 'q_norm': l0_q_norm, 'k_norm': l0_k_norm, 'sink': l0_sink, 'w_o': l0_w_o},
        {'lam_re': l1_lam_re, 'lam_im': l1_lam_im, 'log_dt': l1_log_dt, 'b_re': l1_b_re,
         'b_im': l1_b_im, 'c_re': l1_c_re, 'c_im': l1_c_im, 'd_skip': l1_d_skip, 'w_glu': l1_w_glu},
        {'w_qkv': l2_w_qkv, 'q_norm': l2_q_norm, 'k_norm': l2_k_norm, 'w_o': l2_w_o},
        {'w_qkv': l3_w_qkv, 'q_norm': l3_q_norm, 'k_norm': l3_k_norm, 'sink': l3_sink, 'w_o': l3_w_o},
    )
    caches = ((cache_l0_k, cache_l0_v), state_l1, (cache_l2_k, cache_l2_v), (cache_l3_k, cache_l3_v))

    row, col = grid_positions(x_sample.shape[1])

    h_ctx = x_prompt
    h_lat = x_sample
    new_state = []
    for l in range(DEPTH):
        kind = LAYER_KINDS[l % N_MIXERS] if l < len(LAYER_KINDS) else 'ABC'[l % N_MIXERS]
        p = mixer_params[l]
        ffn_p = (w_up[l], b_up[l], conv_k[l], conv_b[l], w_down[l])

        sh1, sc1, g1, sh2, sc2, g2 = ada_params(c_ctx, w_mod[l], b_mod[l])
        mix, st = context_mixer(kind, p, sublayer_in(h_ctx, norm1[l], sh1, sc1))
        h_ctx = h_ctx + g1 * mix
        h_ctx = h_ctx + g2 * conv_ffn(sublayer_in(h_ctx, norm2[l], sh2, sc2), *ffn_p)
        new_state.append(st)

        sh1, sc1, g1, sh2, sc2, g2 = ada_params(c, w_mod[l], b_mod[l])
        mix = latent_mixer(kind, p, sublayer_in(h_lat, norm1[l], sh1, sc1), caches[l], row, col)
        h_lat = h_lat + g1 * mix
        h_lat = h_lat + g2 * conv_ffn(sublayer_in(h_lat, norm2[l], sh2, sc2), *ffn_p)

    new_l0_k, new_l0_v = new_state[0]
    new_l1_state = new_state[1]
    new_l2_k, new_l2_v = new_state[2]
    new_l3_k, new_l3_v = new_state[3]
    return (h_ctx, h_lat, new_l0_k, new_l0_v, new_l1_state, new_l2_k, new_l2_v, new_l3_k, new_l3_v)
```

```cpp
#include <hip/hip_runtime.h>
#include <hip/hip_cooperative_groups.h>
#include <cstdio>
#include <cstdint>
namespace cg = cooperative_groups;
#ifndef ONE_LAUNCH
#define ONE_LAUNCH 1
#endif
namespace pg8 {
#define PG8_LAS __attribute__((address_space(3)))
typedef unsigned short bf16_t;
typedef short bf16x8 __attribute__((ext_vector_type(8)));
typedef float f32x4 __attribute__((ext_vector_type(4)));
typedef unsigned u32x4 __attribute__((ext_vector_type(4)));
constexpr int BM = 256, BK = 64, HALF = 128, HTB = HALF * BK * 2  , STAGE_BYTES = 8 * HTB, NXCD = 8, WGM = 8;

__host__ __device__ __forceinline__ int lds_byte(int r, int c) { const int st = (r >> 4) * 2 + (c >> 5), rr = r & 15, cc = c & 31, ob = rr * 64 + cc * 2; return st * 1024 + (ob ^ (((ob >> 9) & 1) << 5)); }
__host__ __device__ __forceinline__ void stage_rc(int b, int& R, int& C) { const int st = b / 1024, sb = b % 1024, swz = sb ^ (((sb >> 9) & 1) << 5); R = (st >> 1) * 16 + swz / 64; C = (st & 1) * 32 + (swz % 64) / 2; }
__host__ __device__ __forceinline__ int perm32(int rho) { const int n = rho >> 4, i = rho & 15; return 8 * (i >> 2) + 4 * n + (i & 3); }

struct Unit { int pm, pn; };
struct Gemm { const bf16_t* A; const bf16_t* Bt; int M, N, K; };

struct StaticOrder {
    int nM, nN, nwg, G, c;
    __host__ __device__ void init(int M, int N, int G_, int c_) { nM = M / BM; nN = N / BM; nwg = nM * nN; G = G_; c = c_; }
    __host__ __device__ bool next(int i, Unit& u) const {
        const long L = (long)i * G + c; if (L >= nwg) return false;
        int wgid = (int)L; { const int q = nwg / NXCD, r = nwg % NXCD, xcd = wgid % NXCD, off = wgid / NXCD; wgid = (xcd < r ? xcd * (q + 1) : r * (q + 1) + (xcd - r) * q) + off; }
        const int nig = WGM * nN, gid = wgid / nig, fm = gid * WGM, gsz = (nM - fm) < WGM ? (nM - fm) : WGM;
        u.pm = fm + ((wgid % nig) % gsz); u.pn = (wgid % nig) / gsz; return true;
    }
    __device__ __forceinline__ void a_ready(const Unit&) const {}
    __device__ __forceinline__ void done(const Unit&) const {}
};

__device__ __forceinline__ unsigned cvt_pk_bf16(float lo, float hi) { unsigned r; asm volatile("v_cvt_pk_bf16_f32 %0, %1, %2" : "=v"(r) : "v"(lo), "v"(hi)); return r; }
typedef float f32x2 __attribute__((ext_vector_type(2)));
__device__ __forceinline__ f32x2 gelu_pk(f32x2 v) {
    const f32x2 av = __builtin_elementwise_abs(v), d = av * 0.2316418882f + 1.0f;
    f32x2 t; t.x = __builtin_amdgcn_rcpf(d.x); t.y = __builtin_amdgcn_rcpf(d.y);
    f32x2 q = t * 0.5307027145f + (-0.7265760135f); q = q * t + 0.7107068705f; q = q * t + (-0.142248368f); q = q * t + 0.127414796f; q = q * t;
    const f32x2 s = (v * v) * (-0.72134752044f);
    f32x2 e; e.x = __builtin_amdgcn_exp2f(s.x); e.y = __builtin_amdgcn_exp2f(s.y);
    const f32x2 m = v * (q * e), r = v - m;
    f32x2 o; o.x = v.x < 0.f ? m.x : r.x; o.y = v.y < 0.f ? m.y : r.y; return o;
}

template <int ACT  > struct EpiBf16 {
    static constexpr bool PERM = true, AFTER_DRAIN = false; static_assert(ACT == 0 || ACT == 1, "EpiBf16: ACT is 0 (none) or 1 (gelu_pk)");
    bf16_t* O; int ldc; const float* bias; int split_cols; size_t split_stride; float scale0;
    __device__ __forceinline__ void operator()(const f32x4 (&acc)[2][2][4][2], const Unit& u, int wr, int wc, int fr, int fq) const {
        const int row0 = u.pm * BM + wr * 64 + fr; int colt = u.pn * BM; bf16_t* base = O;
        float sc = 1.f; if (split_cols) { const int t = colt / split_cols; base += (size_t)t * split_stride; colt -= t * split_cols; if (t == 0) sc = scale0; }
        const int col0 = colt + wc * 32 + 8 * fq, bcol0 = u.pn * BM + wc * 32 + 8 * fq;
        f32x4 bv[2][2];
#pragma unroll
        for (int bj = 0; bj < 2; ++bj)
#pragma unroll
            for (int n = 0; n < 2; ++n) bv[bj][n] = bias ? *(const f32x4*)(bias + bcol0 + bj * HALF + 4 * n) : (f32x4){0.f, 0.f, 0.f, 0.f};
#pragma unroll
        for (int ai = 0; ai < 2; ++ai)
#pragma unroll
            for (int m = 0; m < 4; ++m) { bf16_t* rowp = base + (size_t)(row0 + ai * HALF + m * 16) * ldc + col0;
#pragma unroll
                for (int bj = 0; bj < 2; ++bj) { f32x4 v0 = acc[ai][bj][m][0] + bv[bj][0], v1 = acc[ai][bj][m][1] + bv[bj][1];
                    if (ACT == 1) { f32x2 a = gelu_pk((f32x2){v0[0], v0[1]}), b = gelu_pk((f32x2){v0[2], v0[3]}), c = gelu_pk((f32x2){v1[0], v1[1]}), d = gelu_pk((f32x2){v1[2], v1[3]});
                        v0 = (f32x4){a.x, a.y, b.x, b.y}; v1 = (f32x4){c.x, c.y, d.x, d.y}; }
                    v0 = v0 * sc; v1 = v1 * sc; u32x4 w; w.x = cvt_pk_bf16(v0[0], v0[1]); w.y = cvt_pk_bf16(v0[2], v0[3]); w.z = cvt_pk_bf16(v1[0], v1[1]); w.w = cvt_pk_bf16(v1[2], v1[3]);
                    *(u32x4*)(rowp + bj * HALF) = w; } }
    }
};
struct EpiResGate {
    static constexpr bool PERM = false, AFTER_DRAIN = false;
    float* x; const float* mod; int goff;
    __device__ __forceinline__ void operator()(const f32x4 (&acc)[2][2][4][2], const Unit& u, int wr, int wc, int fr, int fq) const {
        const int ci = u.pm < 32 ? 8 : ((u.pm - 32) >> 2);
        const float* g = mod + ci * 6144 + goff;
        const int col0 = u.pn * BM + wc * 32 + 4 * fq;
        f32x4 gv[2][2];
#pragma unroll
        for (int bj = 0; bj < 2; ++bj)
#pragma unroll
            for (int n = 0; n < 2; ++n) gv[bj][n] = *(const f32x4*)(g + col0 + bj * HALF + n * 16);
#pragma unroll
        for (int ai = 0; ai < 2; ++ai)
#pragma unroll
            for (int m = 0; m < 4; ++m) { float* xr = x + (size_t)(u.pm * BM + ai * HALF + wr * 64 + m * 16 + fr) * 1024 + col0;
#pragma unroll
                for (int bj = 0; bj < 2; ++bj)
#pragma unroll
                    for (int n = 0; n < 2; ++n) { f32x4 v = *(const f32x4*)(xr + bj * HALF + n * 16); v = v + gv[bj][n] * acc[ai][bj][m][n]; *(f32x4*)(xr + bj * HALF + n * 16) = v; }
                asm volatile("" ::: "memory"); }
    }
};
struct EpiGlu {
    static constexpr bool PERM = false, AFTER_DRAIN = false;
    float* x; const float* mod; int goff;
    __device__ __forceinline__ void operator()(const f32x4 (&acc)[2][2][4][2], const Unit& u, int wr, int wc, int fr, int fq) const {
        const int ci = u.pm < 32 ? 8 : ((u.pm - 32) >> 2);
        const float* g = mod + ci * 6144 + goff;
        const int col0 = u.pn * HALF + wc * 32 + 4 * fq;
        f32x4 gv[2];
#pragma unroll
        for (int n = 0; n < 2; ++n) gv[n] = *(const f32x4*)(g + col0 + n * 16);
#pragma unroll
        for (int ai = 0; ai < 2; ++ai)
#pragma unroll
            for (int m = 0; m < 4; ++m) { float* xr = x + (size_t)(u.pm * BM + ai * HALF + wr * 64 + m * 16 + fr) * 1024 + col0;
#pragma unroll
                for (int n = 0; n < 2; ++n) { const f32x4 h = acc[ai][0][m][n], hg = acc[ai][1][m][n]; f32x4 s;
#pragma unroll
                    for (int e = 0; e < 4; ++e) s[e] = h[e] / (1.0f + __expf(-hg[e]));
                    f32x4 v = *(const f32x4*)(xr + n * 16); v = v + gv[n] * s; *(f32x4*)(xr + n * 16) = v; }
                asm volatile("" ::: "memory"); }
    }
};

struct EpiMulti {
    static constexpr bool AFTER_DRAIN = false;
    int mode; EpiBf16<0> e0; EpiResGate e1; EpiGlu e2;
    __device__ __forceinline__ bool perm() const { return mode == 0; }
    __device__ __forceinline__ void operator()(const f32x4 (&acc)[2][2][4][2], const Unit& u, int wr, int wc, int fr, int fq) const {
        if (mode == 0) e0(acc, u, wr, wc, fr, fq); else if (mode == 1) e1(acc, u, wr, wc, fr, fq); else e2(acc, u, wr, wc, fr, fq);
    }
};
template <class Epi, class Sched, bool ALIGN_EPI = false, bool SP2 = false>
__device__ __forceinline__ void gemm_phase(PG8_LAS unsigned char* lds, const Gemm g, const Sched& S, const Epi& E, const int tid) {
    const int wid = __builtin_amdgcn_readfirstlane(tid >> 6), lane = tid & 63, wr = wid >> 2, wc = wid & 3, fr = lane & 15, fq = lane >> 4;
    const int K = g.K, nt = K / BK;
    unsigned voffA[2], voffB[2];
#pragma unroll
    for (int i = 0; i < 2; ++i) { int R, C; stage_rc(tid * 16 + i * 8192, R, C); const int Rb = E.perm() ? ((R & ~31) + perm32(R & 31)) : R;
        voffA[i] = (unsigned)(R * K + C) * 2u; voffB[i] = (unsigned)(Rb * K + C) * 2u; }
    const size_t kstep = (size_t)(BK * 2);
    const size_t hstep = (size_t)HALF * K * 2;
    const size_t tstep = 2 * hstep;
    const unsigned ldsw = (unsigned)wid * 1024u;
    const int aoff = lds_byte(wr * 64 + fr, fq * 8), boff = lds_byte(wc * 32 + fr, fq * 8);
#define PG8_SA(b, h) (((b) * 2 + (h)) * HTB)
#define PG8_SB(b, h) ((4 + (b) * 2 + (h)) * HTB)
#define PG8_STAGE(bufoff, gbase, voff) do { _Pragma("unroll") for (int _i = 0; _i < 2; ++_i) \
        __builtin_amdgcn_global_load_lds((const unsigned*)((const char*)(gbase) + (voff)[_i]), (PG8_LAS unsigned*)(lds + (bufoff) + ldsw + _i * 8192), 16, 0, 0); } while (0)
#define PG8_LDA(dst, b, h) do { _Pragma("unroll") for (int m = 0; m < 4; ++m) _Pragma("unroll") for (int k = 0; k < 2; ++k) dst[m][k] = *(const PG8_LAS bf16x8*)(lds + PG8_SA(b, h) + aoff + m * 2048 + k * 1024); } while (0)
#define PG8_LDB(dst, b, h) do { _Pragma("unroll") for (int n = 0; n < 2; ++n) _Pragma("unroll") for (int k = 0; k < 2; ++k) dst[n][k] = *(const PG8_LAS bf16x8*)(lds + PG8_SB(b, h) + boff + n * 2048 + k * 1024); } while (0)
#define PG8_MMA(ai, bj, At, Bt) do { __builtin_amdgcn_s_setprio(1); _Pragma("unroll") for (int m = 0; m < 4; ++m) _Pragma("unroll") for (int n = 0; n < 2; ++n) _Pragma("unroll") for (int k = 0; k < 2; ++k) \
        acc[ai][bj][m][n] = __builtin_amdgcn_mfma_f32_16x16x32_bf16(Bt[n][k], At[m][k], acc[ai][bj][m][n], 0, 0, 0); __builtin_amdgcn_s_setprio(0); } while (0)
#define PG8_WAIT_V(n) asm volatile("s_waitcnt vmcnt(" #n ")" ::: "memory")
#define PG8_WAIT_L(n) asm volatile("s_waitcnt lgkmcnt(" #n ")" ::: "memory")
#define PG8_BAR __builtin_amdgcn_s_barrier()
#define PG8_SCHED __builtin_amdgcn_sched_barrier(0)
    Unit cur, nxt; int ui = 0;
    if (!S.next(0, cur)) return;
    f32x4 acc[2][2][4][2];
#pragma unroll
    for (int a = 0; a < 2; ++a)
#pragma unroll
        for (int b = 0; b < 2; ++b)
#pragma unroll
            for (int m = 0; m < 4; ++m)
#pragma unroll
                for (int n = 0; n < 2; ++n) acc[a][b][m][n] = (f32x4){0.f, 0.f, 0.f, 0.f};
    bf16x8 At[4][2], B0[2][2], B1[2][2];
    const char* cA = (const char*)g.A + (size_t)cur.pm * tstep; const char* cB = (const char*)g.Bt + (size_t)cur.pn * tstep;
    S.a_ready(cur);
    if constexpr (SP2) {
        PG8_STAGE(PG8_SB(0, 0), cB, voffB); PG8_STAGE(PG8_SB(0, 1), cB + hstep, voffB); PG8_STAGE(PG8_SA(0, 0), cA, voffA); PG8_STAGE(PG8_SA(0, 1), cA + hstep, voffA);
        if (wr == 1) PG8_BAR;
        PG8_WAIT_V(2); PG8_BAR;
        PG8_STAGE(PG8_SB(1, 0), cB + kstep, voffB); PG8_STAGE(PG8_SA(1, 0), cA + kstep, voffA); PG8_STAGE(PG8_SB(1, 1), cB + hstep + kstep, voffB);
        PG8_WAIT_V(6); PG8_BAR;
    } else {
        PG8_STAGE(PG8_SB(0, 0), cB, voffB); PG8_STAGE(PG8_SA(0, 0), cA, voffA); PG8_STAGE(PG8_SB(0, 1), cB + hstep, voffB); PG8_STAGE(PG8_SA(0, 1), cA + hstep, voffA);
        if (wr == 1) PG8_BAR;
        PG8_WAIT_V(4); PG8_BAR;
        PG8_STAGE(PG8_SB(1, 0), cB + kstep, voffB); PG8_STAGE(PG8_SA(1, 0), cA + kstep, voffA); PG8_STAGE(PG8_SB(1, 1), cB + hstep + kstep, voffB);
        PG8_WAIT_V(6); PG8_BAR;
    }
    for (;;) {
        const bool has_next = S.next(ui + 1, nxt);
        const char* nA = has_next ? (const char*)g.A + (size_t)nxt.pm * tstep : cA; const char* nB = has_next ? (const char*)g.Bt + (size_t)nxt.pn * tstep : cB;
        for (int t = 0; t < nt; t += 2) {
            const bool last = (t == nt - 2);
            const char* a1 = cA + (size_t)(t + 1) * kstep;
            const char* a2 = last ? nA : cA + (size_t)(t + 2) * kstep; const char* b2 = last ? nB : cB + (size_t)(t + 2) * kstep;
            const char* a3 = a2 + kstep; const char* b3 = b2 + kstep;
            if (last && has_next) S.a_ready(nxt);
            if constexpr (SP2) {
            PG8_LDB(B0, 0, 0); PG8_LDB(B1, 0, 1); PG8_SCHED; PG8_LDA(At, 0, 0); PG8_STAGE(PG8_SA(1, 1), a1 + hstep, voffA);
            PG8_WAIT_V(8); PG8_WAIT_L(0); PG8_BAR; PG8_MMA(0, 0, At, B0); PG8_MMA(0, 1, At, B1); PG8_BAR; PG8_SCHED;
            PG8_LDA(At, 0, 1); PG8_STAGE(PG8_SB(0, 0), b2, voffB); PG8_STAGE(PG8_SB(0, 1), b2 + hstep, voffB); PG8_STAGE(PG8_SA(0, 0), a2, voffA);
            PG8_WAIT_V(8); PG8_WAIT_L(0); PG8_BAR; PG8_MMA(1, 0, At, B0); PG8_MMA(1, 1, At, B1); PG8_BAR; PG8_SCHED;
            PG8_LDB(B0, 1, 0); PG8_LDB(B1, 1, 1); PG8_SCHED; PG8_LDA(At, 1, 0); PG8_STAGE(PG8_SA(0, 1), a2 + hstep, voffA);
            PG8_WAIT_V(8); PG8_WAIT_L(0); PG8_BAR; PG8_MMA(0, 0, At, B0); PG8_MMA(0, 1, At, B1); PG8_BAR; PG8_SCHED;
            PG8_LDA(At, 1, 1); PG8_STAGE(PG8_SB(1, 0), b3, voffB); PG8_STAGE(PG8_SB(1, 1), b3 + hstep, voffB); PG8_STAGE(PG8_SA(1, 0), a3, voffA);
            PG8_WAIT_V(8); PG8_WAIT_L(0); PG8_BAR; PG8_MMA(1, 0, At, B0); PG8_MMA(1, 1, At, B1); PG8_BAR; PG8_SCHED;
            } else {
            PG8_LDB(B0, 0, 0); PG8_SCHED; PG8_LDA(At, 0, 0); PG8_STAGE(PG8_SA(1, 1), a1 + hstep, voffA);
            PG8_WAIT_L(8); PG8_BAR; PG8_WAIT_L(0); PG8_MMA(0, 0, At, B0); PG8_BAR; PG8_SCHED;
            PG8_LDB(B1, 0, 1); PG8_STAGE(PG8_SB(0, 0), b2, voffB);
            PG8_BAR; PG8_WAIT_L(0); PG8_MMA(0, 1, At, B1); PG8_BAR;
            PG8_LDA(At, 0, 1); PG8_STAGE(PG8_SA(0, 0), a2, voffA);
            PG8_BAR; PG8_WAIT_L(0); PG8_MMA(1, 0, At, B0); PG8_BAR; PG8_SCHED;
            PG8_STAGE(PG8_SB(0, 1), b2 + hstep, voffB);
            PG8_WAIT_V(6); PG8_BAR; PG8_MMA(1, 1, At, B1); PG8_BAR;
            PG8_LDB(B0, 1, 0); PG8_SCHED; PG8_LDA(At, 1, 0); PG8_STAGE(PG8_SA(0, 1), a2 + hstep, voffA);
            PG8_WAIT_L(8); PG8_BAR; PG8_WAIT_L(0); PG8_MMA(0, 0, At, B0); PG8_BAR; PG8_SCHED;
            PG8_LDB(B1, 1, 1); PG8_STAGE(PG8_SB(1, 0), b3, voffB);
            PG8_BAR; PG8_WAIT_L(0); PG8_MMA(0, 1, At, B1); PG8_BAR;
            PG8_LDA(At, 1, 1); PG8_STAGE(PG8_SA(1, 0), a3, voffA);
            PG8_BAR; PG8_WAIT_L(0); PG8_MMA(1, 0, At, B0); PG8_BAR; PG8_SCHED;
            PG8_STAGE(PG8_SB(1, 1), b3 + hstep, voffB);
            PG8_WAIT_V(6); PG8_BAR; PG8_MMA(1, 1, At, B1); PG8_BAR;
            }
        }
        if constexpr (ALIGN_EPI) { if (wr == 0) PG8_BAR; }
        if constexpr (!Epi::AFTER_DRAIN) { E(acc, cur, wr, wc, fr, fq); S.done(cur); }
        if (!has_next) break;
#pragma unroll
        for (int a = 0; a < 2; ++a)
#pragma unroll
            for (int b = 0; b < 2; ++b)
#pragma unroll
                for (int m = 0; m < 4; ++m)
#pragma unroll
                    for (int n = 0; n < 2; ++n) acc[a][b][m][n] = (f32x4){0.f, 0.f, 0.f, 0.f};
        cur = nxt; cA = nA; cB = nB; ++ui;
        if constexpr (ALIGN_EPI) { if (wr == 1) PG8_BAR; }
    }
    PG8_WAIT_V(0);
    if constexpr (!ALIGN_EPI) { if (wr == 0) PG8_BAR; }
    PG8_BAR;
    if constexpr (Epi::AFTER_DRAIN) { E.fused(acc, cur, wr, wc, fr, fq, lds, wid, lane); S.done(cur); }
#undef PG8_SA
#undef PG8_SB
#undef PG8_STAGE
#undef PG8_LDA
#undef PG8_LDB
#undef PG8_MMA
#undef PG8_WAIT_V
#undef PG8_WAIT_L
#undef PG8_BAR
#undef PG8_SCHED
}
}

constexpr int D = 1024, MROWS = 16384, NCTX = 8192, FF = 2816, FF2 = 5632;
constexpr float EPS = 1e-6f;
constexpr float LOG2E = 1.4426950408889634f;

constexpr size_t MiB = 1u << 20;
constexpr size_t WS_MOD = 1 * MiB;
constexpr size_t WS_BUPP = 2 * MiB;
constexpr size_t WS_WQKV0 = 3 * MiB, WS_WQKV3 = 6 * MiB, WS_WQKV2 = 9 * MiB;
constexpr size_t WS_WO0 = 13 * MiB, WS_WO2 = 15 * MiB, WS_WO3 = 17 * MiB, WS_WGLU = 19 * MiB;
constexpr size_t WS_WUP = 23 * MiB;
constexpr size_t WS_WDN = 67 * MiB;
constexpr size_t WS_C0K = 89 * MiB, WS_C0V = 91 * MiB, WS_C2K = 93 * MiB, WS_C2V = 97 * MiB, WS_C3K = 101 * MiB, WS_C3V = 103 * MiB;
constexpr size_t WS_ABUF = 106 * MiB;
constexpr size_t WS_XN = 106 * MiB;
constexpr size_t WS_R = 194 * MiB;
constexpr size_t WS_H = WS_R;
constexpr size_t WS_QKV = WS_R;
constexpr size_t WS_QN = WS_R + 64 * MiB;
constexpr size_t WS_KN = WS_R + 96 * MiB;
constexpr size_t WS_OB = WS_R + 112 * MiB;
constexpr size_t WS_YTMP = WS_R;
constexpr size_t WS_GACT = WS_R + 64 * MiB;
constexpr size_t WS_END = 370 * MiB;

#define LAS __attribute__((address_space(3)))
typedef unsigned short bf16;
typedef short bf16x8 __attribute__((ext_vector_type(8)));
typedef short s16x4 __attribute__((ext_vector_type(4)));
typedef float f32x4 __attribute__((ext_vector_type(4)));
typedef float f32x16 __attribute__((ext_vector_type(16)));
typedef unsigned u32x4 __attribute__((ext_vector_type(4)));
typedef unsigned u32x2 __attribute__((ext_vector_type(2)));

__device__ __forceinline__ float bf2f(bf16 v) { return __uint_as_float(((unsigned)v) << 16); }
__device__ __forceinline__ unsigned pk2(float lo, float hi) { return pg8::cvt_pk_bf16(lo, hi); }
__device__ __forceinline__ bf16 f2bf(float v) { return (bf16)(pk2(v, 0.f) & 0xffffu); }
__device__ __forceinline__ float shfl_xor_l(float v, int o, int lane) { return __int_as_float(__builtin_amdgcn_ds_bpermute((lane ^ o) << 2, __float_as_int(v))); }
__device__ __forceinline__ float wave_sum(float v, int lane) {
#pragma unroll
    for (int o = 1; o < 64; o <<= 1) v += shfl_xor_l(v, o, lane);
    return v;
}
__device__ __forceinline__ float fast_sin(float x) { const float r = x * 0.15915494309189535f; return __builtin_amdgcn_sinf(r - floorf(r)); }
__device__ __forceinline__ float fast_cos(float x) { const float r = x * 0.15915494309189535f; return __builtin_amdgcn_cosf(r - floorf(r)); }
__device__ __forceinline__ float silu_f(float v) { return v / (1.0f + __expf(-v)); }
__device__ __forceinline__ float gelu_tanh(float v) {
    const float z = 0.7978845608028654f * (v + 0.044715f * v * v * v);
    const float t = 1.0f - 2.0f / (__expf(2.0f * z) + 1.0f);
    return 0.5f * v * (1.0f + t);
}

struct Args { const float* in[45]; int ph_lo, ph_hi; };
__device__ __forceinline__ const float* inp(const Args& a, int i) { asm volatile("" : "+s"(i)); return a.in[i]; }

__device__ __forceinline__ int map_row(int n0, int mode) {
    if (mode == 1) { const int bj = n0 / FF, r = n0 % FF; return 256 * (r / 128) + 128 * bj + (r % 128); }
    if (mode == 2) { const int bj = n0 / 1024, r = n0 % 1024; return 256 * (r / 128) + 128 * bj + (r % 128); }
    return n0;
}
__device__ __forceinline__ void transpose_item(const float* W, int K, int N, bf16* WT, int mode, LAS float* scr, int item, int lane) {
    const int nblk = N / 32, kb = item / nblk, nb = item % nblk, k0 = 64 * kb, n0 = 32 * nb;
    const int r0 = map_row(n0, mode);
#pragma unroll 8
    for (int i = 0; i < 32; ++i) { const int kk = 2 * i + (lane >> 5); scr[kk * 33 + (lane & 31)] = W[(size_t)(k0 + kk) * N + n0 + (lane & 31)]; }
    asm volatile("s_waitcnt lgkmcnt(0)" ::: "memory"); __builtin_amdgcn_wave_barrier();
    const int c = lane & 7;
#pragma unroll
    for (int j = 0; j < 4; ++j) { const int n = (lane >> 3) + 8 * j; const LAS float* s = scr + (8 * c) * 33 + n;
        u32x4 o; o.x = pk2(s[0 * 33], s[1 * 33]); o.y = pk2(s[2 * 33], s[3 * 33]); o.z = pk2(s[4 * 33], s[5 * 33]); o.w = pk2(s[6 * 33], s[7 * 33]);
        *(u32x4*)(WT + (size_t)(r0 + n) * K + k0 + 8 * c) = o; }
    asm volatile("s_waitcnt lgkmcnt(0)" ::: "memory"); __builtin_amdgcn_wave_barrier();
}
__device__ __forceinline__ void prologue_phase(const Args& a, LAS unsigned char* lds, int tid, int wave, int lane) {
    unsigned char* ws = (unsigned char*)inp(a, 44);
    float* outp = (float*)inp(a, 43);
    const int G = gridDim.x, bx = blockIdx.x;
    {
        LAS float* sc = (LAS float*)lds;
        LAS float* red = (LAS float*)(lds + 36864);
        for (int i = tid; i < 9 * 1024; i += 512) { const int ci = i >> 10, k = i & 1023; const float v = ci < 8 ? inp(a, 9)[ci * 1024 + k] : inp(a, 10)[k]; sc[i] = silu_f(v); }
        __syncthreads();
        float* mod = (float*)(ws + WS_MOD);
        for (int u = bx; u < 4 * 96; u += G) {
            const int l = u / 96, c0 = (u % 96) * 64;
            const float* w = inp(a, 13) + (size_t)l * 1024 * 6144 + c0 + lane;
            float acc[9];
#pragma unroll
            for (int i = 0; i < 9; ++i) acc[i] = 0.f;
            const int kb = wave * 128;
#pragma unroll 4
            for (int k = 0; k < 128; ++k) { const float wv = w[(size_t)(kb + k) * 6144];
#pragma unroll
                for (int i = 0; i < 9; ++i) acc[i] += sc[i * 1024 + kb + k] * wv; }
#pragma unroll
            for (int i = 0; i < 9; ++i) red[(wave * 9 + i) * 64 + lane] = acc[i];
            __syncthreads();
            for (int o = tid; o < 9 * 64; o += 512) { const int i = o >> 6, cc = o & 63; float s = inp(a, 14)[l * 6144 + c0 + cc];
#pragma unroll
                for (int w8 = 0; w8 < 8; ++w8) s += red[(w8 * 9 + i) * 64 + cc];
                mod[((size_t)l * 9 + i) * 6144 + c0 + cc] = s; }
            __syncthreads();
        }
    }
    __syncthreads();
    {
        LAS float* scr = (LAS float*)(lds + wave * 16384);
        const int gw = bx * 8 + wave, NGW = G * 8;
        constexpr int I_QA = 16 * 48, I_QC = 16 * 64, I_O = 16 * 32, I_G = 16 * 64, I_UP = 16 * 176, I_DN = 44 * 32;
        constexpr int NITEMS = 2 * I_QA + I_QC + 3 * I_O + I_G + 4 * I_UP + 4 * I_DN;
        for (int it = gw; it < NITEMS; it += NGW) {
            int r = it;
            if (r < I_QA) { transpose_item(inp(a, 20), 1024, 1536, (bf16*)(ws + WS_WQKV0), 0, scr, r, lane); continue; } r -= I_QA;
            if (r < I_QA) { transpose_item(inp(a, 38), 1024, 1536, (bf16*)(ws + WS_WQKV3), 0, scr, r, lane); continue; } r -= I_QA;
            if (r < I_QC) { transpose_item(inp(a, 34), 1024, 2048, (bf16*)(ws + WS_WQKV2), 0, scr, r, lane); continue; } r -= I_QC;
            if (r < I_O) { transpose_item(inp(a, 24), 1024, 1024, (bf16*)(ws + WS_WO0), 0, scr, r, lane); continue; } r -= I_O;
            if (r < I_O) { transpose_item(inp(a, 37), 1024, 1024, (bf16*)(ws + WS_WO2), 0, scr, r, lane); continue; } r -= I_O;
            if (r < I_O) { transpose_item(inp(a, 42), 1024, 1024, (bf16*)(ws + WS_WO3), 0, scr, r, lane); continue; } r -= I_O;
            if (r < I_G) { transpose_item(inp(a, 33), 1024, 2048, (bf16*)(ws + WS_WGLU), 2, scr, r, lane); continue; } r -= I_G;
            if (r < 4 * I_UP) { const int l = r / I_UP; transpose_item(inp(a, 15) + (size_t)l * 1024 * FF2, 1024, FF2, (bf16*)(ws + WS_WUP) + (size_t)l * FF2 * 1024, 1, scr, r % I_UP, lane); continue; } r -= 4 * I_UP;
            { const int l = r / I_DN; transpose_item(inp(a, 19) + (size_t)l * FF * 1024, FF, 1024, (bf16*)(ws + WS_WDN) + (size_t)l * 1024 * FF, 0, scr, r % I_DN, lane); }
        }
    }
    const size_t gt = (size_t)bx * 512 + tid, NT = (size_t)G * 512;
    for (size_t i = gt; i < (size_t)MROWS * D / 4; i += NT) {
        const size_t half = (size_t)NCTX * D / 4;
        const f32x4 v = i < half ? ((const f32x4*)inp(a, 0))[i] : ((const f32x4*)inp(a, 1))[i - half];
        ((f32x4*)outp)[i] = v;
    }
    {
        const int srcs[6] = {2, 3, 5, 6, 7, 8};
        const size_t dsts[6] = {WS_C0K, WS_C0V, WS_C2K, WS_C2V, WS_C3K, WS_C3V};
        const size_t cnt[6] = {1048576, 1048576, 2097152, 2097152, 1048576, 1048576};
#pragma unroll
        for (int s = 0; s < 6; ++s) {
            const f32x4* src = (const f32x4*)inp(a, srcs[s]); u32x2* dst = (u32x2*)(ws + dsts[s]);
            for (size_t i = gt; i < cnt[s] / 4; i += NT) { const f32x4 v = src[i]; u32x2 o; o.x = pk2(v[0], v[1]); o.y = pk2(v[2], v[3]); dst[i] = o; }
        }
    }
    {
        float* bp = (float*)(ws + WS_BUPP);
        for (size_t i = gt; i < 4 * FF2; i += NT) { const int l = (int)(i / FF2), gc = (int)(i % FF2); const int pn = gc / 256, bj = (gc % 256) / 128, cc = gc % 128;
            bp[i] = inp(a, 16)[l * FF2 + bj * FF + pn * 128 + cc]; }
    }
}

__device__ __forceinline__ void norm_phase(const float* x, const float* gain, const float* mod, int shoff, int scoff, bf16* xn, int wave, int lane) {
    const int gw = blockIdx.x * 8 + wave, NGW = gridDim.x * 8;
    for (int row = gw; row < MROWS; row += NGW) {
        const int ci = row < NCTX ? 8 : ((row - NCTX) >> 10);
        const f32x4* xr = (const f32x4*)(x + (size_t)row * D) + lane;
        f32x4 v[4]; float s = 0.f;
#pragma unroll
        for (int j = 0; j < 4; ++j) { v[j] = xr[64 * j]; s += (v[j][0] * v[j][0] + v[j][1] * v[j][1]) + (v[j][2] * v[j][2] + v[j][3] * v[j][3]); }
        const float rstd = rsqrtf(wave_sum(s, lane) * (1.0f / D) + EPS);
        const float* mrow = mod + ci * 6144;
        u32x2* o8 = (u32x2*)(xn + (size_t)row * D) + lane;
#pragma unroll
        for (int j = 0; j < 4; ++j) {
            const int c = 4 * lane + 256 * j;
            const f32x4 g = *(const f32x4*)(gain + c), sh = *(const f32x4*)(mrow + shoff + c), sc = *(const f32x4*)(mrow + scoff + c);
            f32x4 y;
#pragma unroll
            for (int e = 0; e < 4; ++e) y[e] = (v[j][e] * rstd * g[e]) * (1.0f + sc[e]) + sh[e];
            u32x2 o; o.x = pk2(y[0], y[1]); o.y = pk2(y[2], y[3]); o8[64 * j] = o;
        }
    }
}

template <int DH>
__device__ __forceinline__ void qkprep_phase(const bf16* qkv, int NKV, const float* qg, const float* kg, bf16* qn, bf16* kn, float* outk, float* outv, int wave, int lane) {
    constexpr int LPH = DH / 2, HPI = 64 / LPH, QUARTER = DH / 4, NH = 1024 / DH;
    const int KW = NKV * DH, ldq = 1024 + 2 * KW;
    const int gw = blockIdx.x * 8 + wave, NGW = gridDim.x * 8;
    const float qscale = rsqrtf((float)DH) * LOG2E;
    const int pi = lane % LPH;
    const bool first = pi < QUARTER;
    const int fi = first ? pi : pi - QUARTER;
    const int d1 = first ? pi : DH / 2 + fi, d2 = d1 + QUARTER;
    const float freq = __builtin_amdgcn_exp2f(-(float)fi * (13.287712379549449f / (float)QUARTER));
    for (int row = gw; row < MROWS; row += NGW) {
        const bool lat = row >= NCTX;
        const int t = (row - NCTX) & 1023;
        const float pos = first ? (float)(t >> 6) : (float)(t & 63);
        float cs = 1.f, sn = 0.f;
        if (lat) { const float ang = pos * freq; cs = fast_cos(ang); sn = fast_sin(ang); }
        const bf16* src = qkv + (size_t)row * ldq;
        for (int hb = 0; hb < NH + NKV; hb += HPI) {
            const int head = hb + lane / LPH;
            const bool isk = head >= NH;
            const float x1 = bf2f(src[head * DH + d1]), x2 = bf2f(src[head * DH + d2]);
            float ss = x1 * x1 + x2 * x2;
#pragma unroll
            for (int o = 1; o < LPH; o <<= 1) ss += shfl_xor_l(ss, o, lane);
            const float rstd = rsqrtf(ss * (1.0f / DH) + EPS);
            const float* g = isk ? kg : qg;
            float y1 = x1 * rstd * g[d1], y2 = x2 * rstd * g[d2];
            if (!lat && isk) { float* ok = outk + (size_t)row * KW + (head - NH) * DH; ok[d1] = y1; ok[d2] = y2; }
            if (lat) { const float r1 = y1 * cs - y2 * sn, r2 = y1 * sn + y2 * cs; y1 = r1; y2 = r2; }
            if (!isk) { bf16* q = qn + (size_t)row * 1024 + head * DH; q[d1] = f2bf(y1 * qscale); q[d2] = f2bf(y2 * qscale); }
            else { bf16* k = kn + (size_t)row * KW + (head - NH) * DH; k[d1] = f2bf(y1); k[d2] = f2bf(y2); }
        }
        if (!lat) { const bf16* v = src + 1024 + KW; float* ov = outv + (size_t)row * KW;
            for (int j = lane; j < KW; j += 64) ov[j] = bf2f(v[j]); }
    }
}

template <int DH, bool WIN>
__device__ __forceinline__ void attn_phase(const bf16* qn, const bf16* kn, const bf16* qkv, const bf16* cK, const bf16* cV, const float* sink, bf16* ob,
                                           LAS unsigned char* lds, int tid, int wave, int lane) {
    constexpr int NH = 1024 / DH, NKV = 4, GQ = NH / NKV, KW = NKV * DH, ldq = 1024 + 2 * KW;
    constexpr int KSTR = DH * 2 + 16;
    constexpr int CPR = DH / 8;
    constexpr int NLD = 64 * CPR / 512;
    LAS unsigned char* Ks = lds;
    LAS unsigned char* Vs = lds + 64 * KSTR;
    const int r32 = lane & 31, hi = lane >> 5;
    const int n_lat = 8 * NH * 4, n_ctx = 32 * NH;
    for (int u = blockIdx.x; u < n_lat + n_ctx; u += gridDim.x) {
        const bool lat = u < n_lat;
        int b, h, q0, qrow0, ncache, kstart, ntl;
        if (lat) { b = u / (NH * 4); const int rem = u % (NH * 4); h = rem >> 2; q0 = (rem & 3) * 256; qrow0 = NCTX + b * 1024 + q0; ncache = 8;
            if (WIN) { kstart = q0 >= 128 ? q0 - 128 : 0; const int kend = q0 + 384 < 1024 ? q0 + 384 : 1024; ntl = (kend - kstart) >> 6; } else { kstart = 0; ntl = 16; } }
        else { const int uu = u - n_lat; b = uu / NH; h = uu % NH; q0 = 0; qrow0 = b * 256; ncache = 0; kstart = 0; ntl = 4; }
        const int kvh = h / GQ;
        const int krow0 = lat ? NCTX + b * 1024 : b * 256;
        const int nt = ncache + ntl;
        bf16x8 qf[DH / 16];
        { const bf16* qp = qn + (size_t)(qrow0 + wave * 32 + r32) * 1024 + h * DH + 8 * hi;
#pragma unroll
          for (int d0 = 0; d0 < DH / 16; ++d0) qf[d0] = *(const bf16x8*)(qp + 16 * d0); }
        float m, l;
        if (sink) { m = sink[h] * LOG2E; l = hi == 0 ? 1.f : 0.f; } else { m = -1e30f; l = 0.f; }
        f32x16 o[DH / 32];
#pragma unroll
        for (int db = 0; db < DH / 32; ++db)
#pragma unroll
            for (int r = 0; r < 16; ++r) o[db][r] = 0.f;
        const int qpos = q0 + wave * 32 + r32;
        u32x4 kreg[NLD], vreg[NLD];
        auto issue = [&](int t) {
            const bf16 *kp, *vp; size_t kpitch, vpitch;
            if (t < ncache) { kp = cK + ((size_t)(b * 512 + 64 * t) * NKV + kvh) * DH; vp = cV + ((size_t)(b * 512 + 64 * t) * NKV + kvh) * DH; kpitch = KW; vpitch = KW; }
            else { const int ks = kstart + 64 * (t - ncache); kp = kn + (size_t)(krow0 + ks) * KW + kvh * DH; vp = qkv + (size_t)(krow0 + ks) * ldq + 1024 + KW + kvh * DH; kpitch = KW; vpitch = ldq; }
#pragma unroll
            for (int i = 0; i < NLD; ++i) { const int c = tid + 512 * i, row = c / CPR, cc = c % CPR;
                kreg[i] = *(const u32x4*)(kp + (size_t)row * kpitch + cc * 8); vreg[i] = *(const u32x4*)(vp + (size_t)row * vpitch + cc * 8); }
        };
        issue(0);
        for (int t = 0; t < nt; ++t) {
            __syncthreads();
#pragma unroll
            for (int i = 0; i < NLD; ++i) { const int c = tid + 512 * i, row = c / CPR, cc = c % CPR;
                *(LAS u32x4*)(Ks + row * KSTR + cc * 16) = kreg[i]; *(LAS u32x4*)(Vs + row * KSTR + cc * 16) = vreg[i]; }
            __syncthreads();
            if (t + 1 < nt) issue(t + 1);
            const int kt0 = t < ncache ? -100000 : kstart + 64 * (t - ncache);
            bool active = true;
            if (WIN && lat && t >= ncache) { const int qw = q0 + wave * 32; if (kt0 + 63 < qw - 128 || kt0 > qw + 31 + 128) active = false; }
            if (active) {
                f32x16 p[2];
#pragma unroll
                for (int kh = 0; kh < 2; ++kh) {
#pragma unroll
                    for (int r = 0; r < 16; ++r) p[kh][r] = 0.f;
                    const LAS unsigned char* kb = Ks + (32 * kh + r32) * KSTR + 16 * hi;
#pragma unroll
                    for (int d0 = 0; d0 < DH / 16; ++d0) { const bf16x8 kf = *(const LAS bf16x8*)(kb + 32 * d0); p[kh] = __builtin_amdgcn_mfma_f32_32x32x16_bf16(kf, qf[d0], p[kh], 0, 0, 0); }
                }
                if (WIN && lat && t >= ncache) {
#pragma unroll
                    for (int kh = 0; kh < 2; ++kh)
#pragma unroll
                        for (int r = 0; r < 16; ++r) { const int kpos = kt0 + 32 * kh + (r & 3) + 8 * (r >> 2) + 4 * hi; const int dd = qpos - kpos; if (dd > 128 || dd < -128) p[kh][r] = -1e30f; }
                }
                float mx = p[0][0];
#pragma unroll
                for (int r = 1; r < 16; ++r) mx = fmaxf(mx, p[0][r]);
#pragma unroll
                for (int r = 0; r < 16; ++r) mx = fmaxf(mx, p[1][r]);
                mx = fmaxf(mx, shfl_xor_l(mx, 32, lane));
                const float mn = fmaxf(m, mx), sc = __builtin_amdgcn_exp2f(m - mn); m = mn;
                float ls = 0.f;
#pragma unroll
                for (int kh = 0; kh < 2; ++kh)
#pragma unroll
                    for (int r = 0; r < 16; ++r) { const float e = __builtin_amdgcn_exp2f(p[kh][r] - mn); p[kh][r] = e; ls += e; }
                l = l * sc + ls;
#pragma unroll
                for (int db = 0; db < DH / 32; ++db)
#pragma unroll
                    for (int r = 0; r < 16; ++r) o[db][r] *= sc;
                const int i16 = lane & 15, qq = i16 >> 2, pp = i16 & 3, blk = (lane >> 4) & 1;
#pragma unroll
                for (int kh = 0; kh < 2; ++kh)
#pragma unroll
                    for (int s2 = 0; s2 < 2; ++s2) {
                        u32x4 pw; pw.x = pk2(p[kh][8 * s2 + 0], p[kh][8 * s2 + 1]); pw.y = pk2(p[kh][8 * s2 + 2], p[kh][8 * s2 + 3]); pw.z = pk2(p[kh][8 * s2 + 4], p[kh][8 * s2 + 5]); pw.w = pk2(p[kh][8 * s2 + 6], p[kh][8 * s2 + 7]);
                        const bf16x8 pf = __builtin_bit_cast(bf16x8, pw);
                        const LAS unsigned char* vb = Vs + (32 * kh + 16 * s2 + 4 * hi + qq) * KSTR + 32 * blk + 8 * pp;
#pragma unroll
                        for (int db = 0; db < DH / 32; ++db) {
                            const s16x4 lo = __builtin_bit_cast(s16x4, __builtin_amdgcn_ds_read_tr16_b64_v4i16((LAS s16x4*)(vb + 64 * db)));
                            const s16x4 hh = __builtin_bit_cast(s16x4, __builtin_amdgcn_ds_read_tr16_b64_v4i16((LAS s16x4*)(vb + 64 * db + 8 * KSTR)));
                            const bf16x8 vf = __builtin_shufflevector(lo, hh, 0, 1, 2, 3, 4, 5, 6, 7);
                            o[db] = __builtin_amdgcn_mfma_f32_32x32x16_bf16(vf, pf, o[db], 0, 0, 0);
                        }
                    }
            }
        }
        l += shfl_xor_l(l, 32, lane);
        const float rl = 1.0f / l;
        bf16* op = ob + (size_t)(qrow0 + wave * 32 + r32) * 1024 + h * DH + 4 * hi;
#pragma unroll
        for (int db = 0; db < DH / 32; ++db)
#pragma unroll
            for (int g4 = 0; g4 < 4; ++g4) { u32x2 w; w.x = pk2(o[db][4 * g4] * rl, o[db][4 * g4 + 1] * rl); w.y = pk2(o[db][4 * g4 + 2] * rl, o[db][4 * g4 + 3] * rl);
                *(u32x2*)(op + 32 * db + 8 * g4) = w; }
        __syncthreads();
    }
}

__device__ __forceinline__ void s5_phase(const Args& a, LAS unsigned char* lds, int wave, int lane) {
    constexpr int BU_STR = 132, H_STR = 136, WBYTES = 13056;
    LAS float* Bu = (LAS float*)(lds + wave * WBYTES);
    LAS bf16* Hs = (LAS bf16*)(lds + wave * WBYTES + 16 * BU_STR * 4);
    unsigned char* ws = (unsigned char*)inp(a, 44);
    const bf16* xn = (const bf16*)(ws + WS_XN);
    float* ytmp = (float*)(ws + WS_YTMP);
    bf16* gact = (bf16*)(ws + WS_GACT);
    const float *lam_re = inp(a, 25), *lam_im = inp(a, 26), *log_dt = inp(a, 27), *b_re = inp(a, 28), *b_im = inp(a, 29), *c_re = inp(a, 30), *c_im = inp(a, 31), *dskip = inp(a, 32);
    float* st_out = (float*)inp(a, 43) + 2 * (size_t)NCTX * D + 2 * 2097152;
    const int G = gridDim.x, gw = wave * G + blockIdx.x, NW = 8 * G;
    const int n16 = lane & 15, kq = lane >> 4;
    for (int u = gw; u < 2560; u += NW) {
        const bool lat = u < 512;
        const int seq = lat ? (u >> 6) : ((u - 512) >> 6), g = u & 63;
        const int S = lat ? 1024 : 256, row0 = lat ? NCTX + seq * 1024 : seq * 256;
        const float dsk = dskip[16 * g + n16];
#pragma unroll 1
        for (int dir = 0; dir < 2; ++dir) {
            const int gb = (dir * 64 + g);
            const float dt = __expf(log_dt[gb]);
            float ar, ai;
            { const float lr = lam_re[gb * 64 + lane], li = lam_im[gb * 64 + lane]; const float mag = __expf(lr * dt); ar = mag * fast_cos(li * dt); ai = mag * fast_sin(li * dt); }
            bf16x8 bfr[8], cfr[4];
#pragma unroll
            for (int nt = 0; nt < 8; ++nt) {
                const int j = 16 * nt + n16, pp = j & 63; const bool im = j >= 64;
                const float lr = lam_re[gb * 64 + pp], li = lam_im[gb * 64 + pp]; const float mag = __expf(lr * dt);
                const float are = mag * fast_cos(li * dt), aim = mag * fast_sin(li * dt), den = lr * lr + li * li, nre = are - 1.0f;
                const float fre = (nre * lr + aim * li) / den, fim = (aim * lr - nre * li) / den;
                u32x4 w = {0u, 0u, 0u, 0u};
                if (kq < 2) {
                    const float* br = b_re + ((size_t)gb * 64 + pp) * 16 + 8 * kq; const float* bi = b_im + ((size_t)gb * 64 + pp) * 16 + 8 * kq;
                    float v[8];
#pragma unroll
                    for (int i = 0; i < 8; ++i) v[i] = im ? (fre * bi[i] + fim * br[i]) : (fre * br[i] - fim * bi[i]);
                    w.x = pk2(v[0], v[1]); w.y = pk2(v[2], v[3]); w.z = pk2(v[4], v[5]); w.w = pk2(v[6], v[7]);
                }
                bfr[nt] = __builtin_bit_cast(bf16x8, w);
            }
#pragma unroll
            for (int ks = 0; ks < 4; ++ks) {
                const int k0 = 32 * ks + 8 * kq;
                float v[8];
#pragma unroll
                for (int i = 0; i < 8; ++i) { const int k = k0 + i; v[i] = k < 64 ? c_re[((size_t)gb * 16 + n16) * 64 + k] : -c_im[((size_t)gb * 16 + n16) * 64 + (k - 64)]; }
                u32x4 w; w.x = pk2(v[0], v[1]); w.y = pk2(v[2], v[3]); w.z = pk2(v[4], v[5]); w.w = pk2(v[6], v[7]);
                cfr[ks] = __builtin_bit_cast(bf16x8, w);
            }
            float hr = 0.f, hi_ = 0.f;
            if (lat) { const float* s0 = inp(a, 4) + ((size_t)(seq * 2 + dir) * 2) * 4096 + g * 64 + lane; hr = s0[0]; hi_ = s0[4096]; }
            const int nch = S / 16;
            const bf16* xa = xn + (size_t)row0 * D + 16 * g;
            auto ld_af = [&](int ch) -> u32x4 { const int t0 = dir == 0 ? ch * 16 : S - 16 - ch * 16; u32x4 r = {0u, 0u, 0u, 0u}; if (kq < 2) r = *(const u32x4*)(xa + (size_t)(t0 + n16) * D + 8 * kq); return r; };
            u32x4 afn = ld_af(0);
#pragma unroll 1
            for (int ch = 0; ch < nch; ++ch) {
                const int t0 = dir == 0 ? ch * 16 : S - 16 - ch * 16;
                const bf16x8 af = __builtin_bit_cast(bf16x8, afn);
                if (ch + 1 < nch) afn = ld_af(ch + 1);
                float yt[4], us[4];
                if (dir == 1) {
#pragma unroll
                    for (int i = 0; i < 4; ++i) { const size_t off = (size_t)(row0 + t0 + 4 * kq + i) * D + 16 * g + n16; yt[i] = ytmp[off]; us[i] = bf2f(xn[off]); }
                }
#pragma unroll
                for (int nt = 0; nt < 8; ++nt) {
                    f32x4 acc = {0.f, 0.f, 0.f, 0.f};
                    acc = __builtin_amdgcn_mfma_f32_16x16x32_bf16(af, bfr[nt], acc, 0, 0, 0);
#pragma unroll
                    for (int i = 0; i < 4; ++i) Bu[(4 * kq + i) * BU_STR + 16 * nt + n16] = acc[i];
                }
                asm volatile("s_waitcnt lgkmcnt(0)" ::: "memory"); __builtin_amdgcn_wave_barrier();
#pragma unroll
                for (int s = 0; s < 16; ++s) {
                    const int tt = dir == 0 ? s : 15 - s;
                    const float br = Bu[tt * BU_STR + lane], bi = Bu[tt * BU_STR + 64 + lane];
                    const float nr = ar * hr - ai * hi_ + br, ni = ar * hi_ + ai * hr + bi;
                    hr = nr; hi_ = ni;
                    Hs[tt * H_STR + lane] = f2bf(hr); Hs[tt * H_STR + 64 + lane] = f2bf(hi_);
                }
                asm volatile("s_waitcnt lgkmcnt(0)" ::: "memory"); __builtin_amdgcn_wave_barrier();
                f32x4 y = {0.f, 0.f, 0.f, 0.f};
#pragma unroll
                for (int ks = 0; ks < 4; ++ks) { const bf16x8 hf = *(const LAS bf16x8*)(Hs + n16 * H_STR + 32 * ks + 8 * kq); y = __builtin_amdgcn_mfma_f32_16x16x32_bf16(hf, cfr[ks], y, 0, 0, 0); }
                asm volatile("s_waitcnt lgkmcnt(0)" ::: "memory"); __builtin_amdgcn_wave_barrier();
#pragma unroll
                for (int i = 0; i < 4; ++i) {
                    const size_t off = (size_t)(row0 + t0 + 4 * kq + i) * D + 16 * g + n16;
                    if (dir == 0) ytmp[off] = y[i];
                    else gact[off] = f2bf(gelu_tanh(yt[i] + y[i] + us[i] * dsk));
                }
            }
            if (!lat) { float* so = st_out + ((size_t)(seq * 2 + dir) * 2) * 4096 + g * 64 + lane; so[0] = hr; so[4096] = hi_; }
        }
    }
}

__device__ __forceinline__ void conv_phase(const bf16* h, const float* ck, const float* cb, bf16* abuf, int tid) {
    const size_t NT = (size_t)gridDim.x * 512;
    for (size_t task = (size_t)blockIdx.x * 512 + tid; task < (size_t)352 * 1024; task += NT) {
        const int cgp = (int)(task % 352), rc = (int)(task / 352);
        const int j0 = cgp * 8, pn = j0 >> 7, jj = j0 & 127, hcol = 256 * pn + jj;
        const int r0 = rc * 16, L = r0 < NCTX ? 256 : 1024;
        const bool pv = (r0 % L) != 0, nv = ((r0 + 16) % L) != 0;
        float k0g[8], k1g[8], k2g[8], bg[8], k0v[8], k1v[8], k2v[8], bv[8];
#pragma unroll
        for (int e = 0; e < 8; ++e) { k0g[e] = ck[j0 + e]; k1g[e] = ck[FF2 + j0 + e]; k2g[e] = ck[2 * FF2 + j0 + e]; bg[e] = cb[j0 + e];
            k0v[e] = ck[FF + j0 + e]; k1v[e] = ck[FF2 + FF + j0 + e]; k2v[e] = ck[2 * FF2 + FF + j0 + e]; bv[e] = cb[FF + j0 + e]; }
        const bf16* hp = h + (size_t)r0 * FF2 + hcol;
        const u32x4 z = {0u, 0u, 0u, 0u};
        u32x4 gp = pv ? *(const u32x4*)(hp - FF2) : z, vp = pv ? *(const u32x4*)(hp - FF2 + 128) : z;
        u32x4 gc = *(const u32x4*)(hp), vc = *(const u32x4*)(hp + 128);
#pragma unroll 4
        for (int i = 0; i < 16; ++i) {
            const bool has = (i < 15) || nv;
            const u32x4 gn = has ? *(const u32x4*)(hp + (size_t)(i + 1) * FF2) : z, vn = has ? *(const u32x4*)(hp + (size_t)(i + 1) * FF2 + 128) : z;
            float o[8];
#pragma unroll
            for (int e = 0; e < 8; ++e) {
                const float a0 = __uint_as_float((e & 1) ? (gp[e >> 1] & 0xffff0000u) : (gp[e >> 1] << 16));
                const float a1 = __uint_as_float((e & 1) ? (gc[e >> 1] & 0xffff0000u) : (gc[e >> 1] << 16));
                const float a2 = __uint_as_float((e & 1) ? (gn[e >> 1] & 0xffff0000u) : (gn[e >> 1] << 16));
                const float b0 = __uint_as_float((e & 1) ? (vp[e >> 1] & 0xffff0000u) : (vp[e >> 1] << 16));
                const float b1 = __uint_as_float((e & 1) ? (vc[e >> 1] & 0xffff0000u) : (vc[e >> 1] << 16));
                const float b2 = __uint_as_float((e & 1) ? (vn[e >> 1] & 0xffff0000u) : (vn[e >> 1] << 16));
                const float gt = bg[e] + k0g[e] * a0 + k1g[e] * a1 + k2g[e] * a2;
                const float vl = bv[e] + k0v[e] * b0 + k1v[e] * b1 + k2v[e] * b2;
                o[e] = silu_f(gt) * vl;
            }
            u32x4 w; w.x = pk2(o[0], o[1]); w.y = pk2(o[2], o[3]); w.z = pk2(o[4], o[5]); w.w = pk2(o[6], o[7]);
            *(u32x4*)(abuf + (size_t)(r0 + i) * FF + j0) = w;
            gp = gc; vp = vc; gc = gn; vc = vn;
        }
    }
}

constexpr int LDS_BYTES = 147456;
constexpr int NPHASE = 37;
__global__ void __launch_bounds__(512, 2) hybrid_fwd(Args a) {
    extern __shared__ __attribute__((aligned(16))) unsigned char lds_raw[];
    LAS unsigned char* lds = (LAS unsigned char*)lds_raw;
    cg::grid_group grid = cg::this_grid();
    bool first = true;
    for (int ph = a.ph_lo; ph < a.ph_hi; ++ph) {
        int tid = threadIdx.x; asm volatile("" : "+v"(tid));
        const int lane = tid & 63, wave = __builtin_amdgcn_readfirstlane(tid >> 6);
        unsigned char* ws = (unsigned char*)inp(a, 44);
        float* x = (float*)inp(a, 43);
        bf16* xn = (bf16*)(ws + WS_XN);
        const int l = (ph - 1) / 9, sub = (ph - 1) % 9;
        if (ph > 0 && l == 1 && (sub == 3 || sub == 4)) continue;
        if (!first) grid.sync();
        first = false;
        #ifndef NO_PRO
        if (ph == 0) { prologue_phase(a, lds, tid, wave, lane); continue; }
#endif
        const float* mod = (const float*)(ws + WS_MOD) + (size_t)l * 9 * 6144;
        const int kind = (l == 1) ? 1 : (l == 2 ? 2 : 0);
        const int nqkv = kind == 2 ? 2048 : 1536;
        bf16* qkv = (bf16*)(ws + WS_QKV); bf16* qn = (bf16*)(ws + WS_QN); bf16* kn = (bf16*)(ws + WS_KN); bf16* ob = (bf16*)(ws + WS_OB);
#ifndef NO_NORM
        if (sub == 0) { norm_phase(x, inp(a, 11) + l * D, mod, 0, 1024, xn, wave, lane); continue; }
        if (sub == 5) { norm_phase(x, inp(a, 12) + l * D, mod, 3072, 4096, xn, wave, lane); continue; }
#endif
#ifndef NO_GEMM
        {
            const bool isg = (sub == 1 && kind != 1) || sub == 6 || (sub == 4 && kind != 1) || sub == 8 || (sub == 2 && kind == 1);
            if (isg) {
                pg8::Gemm g; pg8::EpiMulti E;
                E.e0 = pg8::EpiBf16<0>{qkv, nqkv, nullptr, 0, 0, 1.f}; E.e1 = pg8::EpiResGate{x, mod, 2048}; E.e2 = pg8::EpiGlu{x, mod, 2048};
                if (sub == 1) { const bf16* wt = (const bf16*)(ws + (l == 0 ? WS_WQKV0 : (l == 2 ? WS_WQKV2 : WS_WQKV3))); g = pg8::Gemm{xn, wt, MROWS, nqkv, D}; E.mode = 0; }
                else if (sub == 6) { g = pg8::Gemm{xn, (const bf16*)(ws + WS_WUP) + (size_t)l * FF2 * 1024, MROWS, FF2, D}; E.mode = 0;
                    E.e0 = pg8::EpiBf16<0>{(bf16*)(ws + WS_H), FF2, (const float*)(ws + WS_BUPP) + l * FF2, 0, 0, 1.f}; }
                else if (sub == 4) { const bf16* wt = (const bf16*)(ws + (l == 0 ? WS_WO0 : (l == 2 ? WS_WO2 : WS_WO3))); g = pg8::Gemm{ob, wt, MROWS, D, D}; E.mode = 1; }
                else if (sub == 8) { g = pg8::Gemm{(const bf16*)(ws + WS_ABUF), (const bf16*)(ws + WS_WDN) + (size_t)l * 1024 * FF, MROWS, D, FF}; E.mode = 1; E.e1.goff = 5120; }
                else { g = pg8::Gemm{(const bf16*)(ws + WS_GACT), (const bf16*)(ws + WS_WGLU), MROWS, 2048, D}; E.mode = 2; }
                pg8::StaticOrder S; S.init(g.M, g.N, gridDim.x, (int)blockIdx.x);
                pg8::gemm_phase<pg8::EpiMulti, pg8::StaticOrder, true, true>(lds, g, S, E, tid);
                continue;
            }
        }
#endif
#ifndef NO_CONV
        if (sub == 7) { conv_phase((const bf16*)(ws + WS_H), inp(a, 17) + (size_t)l * 3 * FF2, inp(a, 18) + (size_t)l * FF2, (bf16*)(ws + WS_ABUF), tid); continue; }
#endif
        if (kind == 1) {
#ifndef NO_S5
            if (sub == 1) { s5_phase(a, lds, wave, lane); continue; }
#endif
            continue;
        }
        float* o_k = x + 2 * (size_t)NCTX * D + (l == 0 ? 0 : (l == 2 ? 2 * 2097152 + 524288 : 2 * 2097152 + 524288 + 2 * 4194304));
#ifndef NO_QKP
        if (sub == 2) {
            if (kind == 0) qkprep_phase<64>(qkv, 4, inp(a, l == 0 ? 21 : 39), inp(a, l == 0 ? 22 : 40), qn, kn, o_k, o_k + 2097152, wave, lane);
            else qkprep_phase<128>(qkv, 4, inp(a, 35), inp(a, 36), qn, kn, o_k, o_k + 4194304, wave, lane);
            continue;
        }
#endif
#ifndef NO_ATT
        if (sub == 3) {
            if (kind == 0) attn_phase<64, true>(qn, kn, qkv, (const bf16*)(ws + (l == 0 ? WS_C0K : WS_C3K)), (const bf16*)(ws + (l == 0 ? WS_C0V : WS_C3V)), inp(a, l == 0 ? 23 : 41), ob, lds, tid, wave, lane);
            else attn_phase<128, false>(qn, kn, qkv, (const bf16*)(ws + WS_C2K), (const bf16*)(ws + WS_C2V), nullptr, ob, lds, tid, wave, lane);
            continue;
        }
#endif
    }
}

extern "C" void kernel_launch(void* const* d_in, const int* in_sizes, int n_in, void* d_out, int out_size, void* d_ws, size_t ws_size, hipStream_t stream) {
    static int grid = 0;
    if (grid == 0) {
        if (n_in != 43 || ws_size < WS_END) { fprintf(stderr, "kernel_launch: unexpected n_in %d / ws_size %zu (need %zu)\n", n_in, ws_size, (size_t)WS_END); grid = -1; return; }
        int dev = 0, cus = 0, per_cu = 0;
        hipGetDevice(&dev);
        hipDeviceGetAttribute(&cus, hipDeviceAttributeMultiprocessorCount, dev);
        hipFuncSetAttribute((const void*)hybrid_fwd, hipFuncAttributeMaxDynamicSharedMemorySize, LDS_BYTES);
        hipOccupancyMaxActiveBlocksPerMultiprocessor(&per_cu, (const void*)hybrid_fwd, 512, LDS_BYTES);
        if (per_cu < 1) per_cu = 1;
        (void)hipGetLastError();
        grid = cus * per_cu;
        if (grid > 256) grid = 256;
    }
    if (grid < 0) return;
    Args a{};
    for (int i = 0; i < 43; ++i) a.in[i] = (const float*)d_in[i];
    a.in[43] = (const float*)d_out; a.in[44] = (const float*)d_ws;
#if ONE_LAUNCH
    a.ph_lo = 0; a.ph_hi = NPHASE;
    void* kargs[] = {&a};
    hipError_t e = hipLaunchCooperativeKernel((const void*)hybrid_fwd, dim3(grid), dim3(512), kargs, LDS_BYTES, stream);
    if (e != hipSuccess) fprintf(stderr, "cooperative launch failed: %s (grid %d)\n", hipGetErrorString(e), grid);
#else
    for (int ph = 0; ph < NPHASE; ++ph) {
        const int l = (ph - 1) / 9, sub = (ph - 1) % 9;
        if (ph > 0 && l == 1 && (sub == 3 || sub == 4)) continue;
        a.ph_lo = ph; a.ph_hi = ph + 1;
        hipLaunchKernelGGL(hybrid_fwd, dim3(grid), dim3(512), LDS_BYTES, stream, a);
    }
#endif
}
```

```cpp
#include <hip/hip_runtime.h>
#include <hip/hip_cooperative_groups.h>
#include <cstdio>
#include <cstdint>
namespace cg = cooperative_groups;
#ifndef ONE_LAUNCH
#define ONE_LAUNCH 1
#endif
#ifndef PROBE_DUP
#define PROBE_DUP -1
#endif
namespace pg8 {
#define PG8_LAS __attribute__((address_space(3)))
typedef unsigned short bf16_t;
typedef short bf16x8 __attribute__((ext_vector_type(8)));
typedef float f32x4 __attribute__((ext_vector_type(4)));
typedef unsigned u32x4 __attribute__((ext_vector_type(4)));
constexpr int BM = 256, BK = 64, HALF = 128, HTB = HALF * BK * 2  , STAGE_BYTES = 8 * HTB, NXCD = 8, WGM = 8;

__host__ __device__ __forceinline__ int lds_byte(int r, int c) { const int st = (r >> 4) * 2 + (c >> 5), rr = r & 15, cc = c & 31, ob = rr * 64 + cc * 2; return st * 1024 + (ob ^ (((ob >> 9) & 1) << 5)); }
__host__ __device__ __forceinline__ void stage_rc(int b, int& R, int& C) { const int st = b / 1024, sb = b % 1024, swz = sb ^ (((sb >> 9) & 1) << 5); R = (st >> 1) * 16 + swz / 64; C = (st & 1) * 32 + (swz % 64) / 2; }
__host__ __device__ __forceinline__ int perm32(int rho) { const int n = rho >> 4, i = rho & 15; return 8 * (i >> 2) + 4 * n + (i & 3); }

struct Unit { int pm, pn; };
struct Gemm { const bf16_t* A; const bf16_t* Bt; int M, N, K; };

struct StaticOrder {
    int nM, nN, nwg, G, c;
    __host__ __device__ void init(int M, int N, int G_, int c_) { nM = M / BM; nN = N / BM; nwg = nM * nN; G = G_; c = c_; }
    __host__ __device__ bool next(int i, Unit& u) const {
        const long L = (long)i * G + c; if (L >= nwg) return false;
        int wgid = (int)L; { const int q = nwg / NXCD, r = nwg % NXCD, xcd = wgid % NXCD, off = wgid / NXCD; wgid = (xcd < r ? xcd * (q + 1) : r * (q + 1) + (xcd - r) * q) + off; }
        const int nig = WGM * nN, gid = wgid / nig, fm = gid * WGM, gsz = (nM - fm) < WGM ? (nM - fm) : WGM;
        u.pm = fm + ((wgid % nig) % gsz); u.pn = (wgid % nig) / gsz; return true;
    }
    __device__ __forceinline__ void a_ready(const Unit&) const {}
    __device__ __forceinline__ void done(const Unit&) const {}
};

__device__ __forceinline__ unsigned cvt_pk_bf16(float lo, float hi) { unsigned r; asm volatile("v_cvt_pk_bf16_f32 %0, %1, %2" : "=v"(r) : "v"(lo), "v"(hi)); return r; }
typedef float f32x2 __attribute__((ext_vector_type(2)));
__device__ __forceinline__ f32x2 gelu_pk(f32x2 v) {
    const f32x2 av = __builtin_elementwise_abs(v), d = av * 0.2316418882f + 1.0f;
    f32x2 t; t.x = __builtin_amdgcn_rcpf(d.x); t.y = __builtin_amdgcn_rcpf(d.y);
    f32x2 q = t * 0.5307027145f + (-0.7265760135f); q = q * t + 0.7107068705f; q = q * t + (-0.142248368f); q = q * t + 0.127414796f; q = q * t;
    const f32x2 s = (v * v) * (-0.72134752044f);
    f32x2 e; e.x = __builtin_amdgcn_exp2f(s.x); e.y = __builtin_amdgcn_exp2f(s.y);
    const f32x2 m = v * (q * e), r = v - m;
    f32x2 o; o.x = v.x < 0.f ? m.x : r.x; o.y = v.y < 0.f ? m.y : r.y; return o;
}

template <int ACT  > struct EpiBf16 {
    static constexpr bool PERM = true, AFTER_DRAIN = false; static_assert(ACT == 0 || ACT == 1, "EpiBf16: ACT is 0 (none) or 1 (gelu_pk)");
    bf16_t* O; int ldc; const float* bias; int split_cols; size_t split_stride; float scale0;
    __device__ __forceinline__ void operator()(const f32x4 (&acc)[2][2][4][2], const Unit& u, int wr, int wc, int fr, int fq) const {
        const int row0 = u.pm * BM + wr * 64 + fr; int colt = u.pn * BM; bf16_t* base = O;
        float sc = 1.f; if (split_cols) { const int t = colt / split_cols; base += (size_t)t * split_stride; colt -= t * split_cols; if (t == 0) sc = scale0; }
        const int col0 = colt + wc * 32 + 8 * fq, bcol0 = u.pn * BM + wc * 32 + 8 * fq;
        f32x4 bv[2][2];
#pragma unroll
        for (int bj = 0; bj < 2; ++bj)
#pragma unroll
            for (int n = 0; n < 2; ++n) bv[bj][n] = bias ? *(const f32x4*)(bias + bcol0 + bj * HALF + 4 * n) : (f32x4){0.f, 0.f, 0.f, 0.f};
#pragma unroll
        for (int ai = 0; ai < 2; ++ai)
#pragma unroll
            for (int m = 0; m < 4; ++m) { bf16_t* rowp = base + (size_t)(row0 + ai * HALF + m * 16) * ldc + col0;
#pragma unroll
                for (int bj = 0; bj < 2; ++bj) { f32x4 v0 = acc[ai][bj][m][0] + bv[bj][0], v1 = acc[ai][bj][m][1] + bv[bj][1];
                    if (ACT == 1) { f32x2 a = gelu_pk((f32x2){v0[0], v0[1]}), b = gelu_pk((f32x2){v0[2], v0[3]}), c = gelu_pk((f32x2){v1[0], v1[1]}), d = gelu_pk((f32x2){v1[2], v1[3]});
                        v0 = (f32x4){a.x, a.y, b.x, b.y}; v1 = (f32x4){c.x, c.y, d.x, d.y}; }
                    v0 = v0 * sc; v1 = v1 * sc; u32x4 w; w.x = cvt_pk_bf16(v0[0], v0[1]); w.y = cvt_pk_bf16(v0[2], v0[3]); w.z = cvt_pk_bf16(v1[0], v1[1]); w.w = cvt_pk_bf16(v1[2], v1[3]);
                    *(u32x4*)(rowp + bj * HALF) = w; } }
    }
};
struct EpiResGate {
    static constexpr bool PERM = false, AFTER_DRAIN = false;
    float* x; const float* mod; int goff;
    __device__ __forceinline__ void operator()(const f32x4 (&acc)[2][2][4][2], const Unit& u, int wr, int wc, int fr, int fq) const {
        const int ci = u.pm < 32 ? 8 : ((u.pm - 32) >> 2);
        const float* g = mod + ci * 6144 + goff;
        const int col0 = u.pn * BM + wc * 32 + 4 * fq;
        f32x4 gv[2][2];
#pragma unroll
        for (int bj = 0; bj < 2; ++bj)
#pragma unroll
            for (int n = 0; n < 2; ++n) gv[bj][n] = *(const f32x4*)(g + col0 + bj * HALF + n * 16);
#pragma unroll
        for (int ai = 0; ai < 2; ++ai)
#pragma unroll
            for (int m = 0; m < 4; ++m) { float* xr = x + (size_t)(u.pm * BM + ai * HALF + wr * 64 + m * 16 + fr) * 1024 + col0;
#pragma unroll
                for (int bj = 0; bj < 2; ++bj)
#pragma unroll
                    for (int n = 0; n < 2; ++n) { f32x4 v = *(const f32x4*)(xr + bj * HALF + n * 16); v = v + gv[bj][n] * acc[ai][bj][m][n]; *(f32x4*)(xr + bj * HALF + n * 16) = v; }
                asm volatile("" ::: "memory"); }
    }
};
struct EpiGlu {
    static constexpr bool PERM = false, AFTER_DRAIN = false;
    float* x; const float* mod; int goff;
    __device__ __forceinline__ void operator()(const f32x4 (&acc)[2][2][4][2], const Unit& u, int wr, int wc, int fr, int fq) const {
        const int ci = u.pm < 32 ? 8 : ((u.pm - 32) >> 2);
        const float* g = mod + ci * 6144 + goff;
        const int col0 = u.pn * HALF + wc * 32 + 4 * fq;
        f32x4 gv[2];
#pragma unroll
        for (int n = 0; n < 2; ++n) gv[n] = *(const f32x4*)(g + col0 + n * 16);
#pragma unroll
        for (int ai = 0; ai < 2; ++ai)
#pragma unroll
            for (int m = 0; m < 4; ++m) { float* xr = x + (size_t)(u.pm * BM + ai * HALF + wr * 64 + m * 16 + fr) * 1024 + col0;
#pragma unroll
                for (int n = 0; n < 2; ++n) { const f32x4 h = acc[ai][0][m][n], hg = acc[ai][1][m][n]; f32x4 s;
#pragma unroll
                    for (int e = 0; e < 4; ++e) s[e] = h[e] / (1.0f + __expf(-hg[e]));
                    f32x4 v = *(const f32x4*)(xr + n * 16); v = v + gv[n] * s; *(f32x4*)(xr + n * 16) = v; }
                asm volatile("" ::: "memory"); }
    }
};

struct EpiMulti {
    static constexpr bool AFTER_DRAIN = false;
    int mode; EpiBf16<0> e0; EpiResGate e1; EpiGlu e2;
    __device__ __forceinline__ bool perm() const { return mode == 0; }
    __device__ __forceinline__ void operator()(const f32x4 (&acc)[2][2][4][2], const Unit& u, int wr, int wc, int fr, int fq) const {
        if (mode == 0) e0(acc, u, wr, wc, fr, fq); else if (mode == 1) e1(acc, u, wr, wc, fr, fq); else e2(acc, u, wr, wc, fr, fq);
    }
};
template <class Epi, class Sched, bool ALIGN_EPI = false, bool SP2 = false>
__device__ __forceinline__ void gemm_phase(PG8_LAS unsigned char* lds, const Gemm g, const Sched& S, const Epi& E, const int tid) {
    const int wid = __builtin_amdgcn_readfirstlane(tid >> 6), lane = tid & 63, wr = wid >> 2, wc = wid & 3, fr = lane & 15, fq = lane >> 4;
    const int K = g.K, nt = K / BK;
    unsigned voffA[2], voffB[2];
#pragma unroll
    for (int i = 0; i < 2; ++i) { int R, C; stage_rc(tid * 16 + i * 8192, R, C); const int Rb = E.perm() ? ((R & ~31) + perm32(R & 31)) : R;
        voffA[i] = (unsigned)(R * K + C) * 2u; voffB[i] = (unsigned)(Rb * K + C) * 2u; }
    const size_t kstep = (size_t)(BK * 2);
    const size_t hstep = (size_t)HALF * K * 2;
    const size_t tstep = 2 * hstep;
    const unsigned ldsw = (unsigned)wid * 1024u;
    const int aoff = lds_byte(wr * 64 + fr, fq * 8), boff = lds_byte(wc * 32 + fr, fq * 8);
#define PG8_SA(b, h) (((b) * 2 + (h)) * HTB)
#define PG8_SB(b, h) ((4 + (b) * 2 + (h)) * HTB)
#define PG8_STAGE(bufoff, gbase, voff) do { _Pragma("unroll") for (int _i = 0; _i < 2; ++_i) \
        __builtin_amdgcn_global_load_lds((const unsigned*)((const char*)(gbase) + (voff)[_i]), (PG8_LAS unsigned*)(lds + (bufoff) + ldsw + _i * 8192), 16, 0, 0); } while (0)
#define PG8_LDA(dst, b, h) do { _Pragma("unroll") for (int m = 0; m < 4; ++m) _Pragma("unroll") for (int k = 0; k < 2; ++k) dst[m][k] = *(const PG8_LAS bf16x8*)(lds + PG8_SA(b, h) + aoff + m * 2048 + k * 1024); } while (0)
#define PG8_LDB(dst, b, h) do { _Pragma("unroll") for (int n = 0; n < 2; ++n) _Pragma("unroll") for (int k = 0; k < 2; ++k) dst[n][k] = *(const PG8_LAS bf16x8*)(lds + PG8_SB(b, h) + boff + n * 2048 + k * 1024); } while (0)
#define PG8_MMA(ai, bj, At, Bt) do { __builtin_amdgcn_s_setprio(1); _Pragma("unroll") for (int m = 0; m < 4; ++m) _Pragma("unroll") for (int n = 0; n < 2; ++n) _Pragma("unroll") for (int k = 0; k < 2; ++k) \
        acc[ai][bj][m][n] = __builtin_amdgcn_mfma_f32_16x16x32_bf16(Bt[n][k], At[m][k], acc[ai][bj][m][n], 0, 0, 0); __builtin_amdgcn_s_setprio(0); } while (0)
#define PG8_WAIT_V(n) asm volatile("s_waitcnt vmcnt(" #n ")" ::: "memory")
#define PG8_WAIT_L(n) asm volatile("s_waitcnt lgkmcnt(" #n ")" ::: "memory")
#define PG8_BAR __builtin_amdgcn_s_barrier()
#define PG8_SCHED __builtin_amdgcn_sched_barrier(0)
    Unit cur, nxt; int ui = 0;
    if (!S.next(0, cur)) return;
    f32x4 acc[2][2][4][2];
#pragma unroll
    for (int a = 0; a < 2; ++a)
#pragma unroll
        for (int b = 0; b < 2; ++b)
#pragma unroll
            for (int m = 0; m < 4; ++m)
#pragma unroll
                for (int n = 0; n < 2; ++n) acc[a][b][m][n] = (f32x4){0.f, 0.f, 0.f, 0.f};
    bf16x8 At[4][2], B0[2][2], B1[2][2];
    const char* cA = (const char*)g.A + (size_t)cur.pm * tstep; const char* cB = (const char*)g.Bt + (size_t)cur.pn * tstep;
    S.a_ready(cur);
    if constexpr (SP2) {
        PG8_STAGE(PG8_SB(0, 0), cB, voffB); PG8_STAGE(PG8_SB(0, 1), cB + hstep, voffB); PG8_STAGE(PG8_SA(0, 0), cA, voffA); PG8_STAGE(PG8_SA(0, 1), cA + hstep, voffA);
        if (wr == 1) PG8_BAR;
        PG8_WAIT_V(2); PG8_BAR;
        PG8_STAGE(PG8_SB(1, 0), cB + kstep, voffB); PG8_STAGE(PG8_SA(1, 0), cA + kstep, voffA); PG8_STAGE(PG8_SB(1, 1), cB + hstep + kstep, voffB);
        PG8_WAIT_V(6); PG8_BAR;
    } else {
        PG8_STAGE(PG8_SB(0, 0), cB, voffB); PG8_STAGE(PG8_SA(0, 0), cA, voffA); PG8_STAGE(PG8_SB(0, 1), cB + hstep, voffB); PG8_STAGE(PG8_SA(0, 1), cA + hstep, voffA);
        if (wr == 1) PG8_BAR;
        PG8_WAIT_V(4); PG8_BAR;
        PG8_STAGE(PG8_SB(1, 0), cB + kstep, voffB); PG8_STAGE(PG8_SA(1, 0), cA + kstep, voffA); PG8_STAGE(PG8_SB(1, 1), cB + hstep + kstep, voffB);
        PG8_WAIT_V(6); PG8_BAR;
    }
    for (;;) {
        const bool has_next = S.next(ui + 1, nxt);
        const char* nA = has_next ? (const char*)g.A + (size_t)nxt.pm * tstep : cA; const char* nB = has_next ? (const char*)g.Bt + (size_t)nxt.pn * tstep : cB;
        for (int t = 0; t < nt; t += 2) {
            const bool last = (t == nt - 2);
            const char* a1 = cA + (size_t)(t + 1) * kstep;
            const char* a2 = last ? nA : cA + (size_t)(t + 2) * kstep; const char* b2 = last ? nB : cB + (size_t)(t + 2) * kstep;
            const char* a3 = a2 + kstep; const char* b3 = b2 + kstep;
            if (last && has_next) S.a_ready(nxt);
            if constexpr (SP2) {
            PG8_LDB(B0, 0, 0); PG8_LDB(B1, 0, 1); PG8_SCHED; PG8_LDA(At, 0, 0); PG8_STAGE(PG8_SA(1, 1), a1 + hstep, voffA);
            PG8_WAIT_V(8); PG8_WAIT_L(0); PG8_BAR; PG8_MMA(0, 0, At, B0); PG8_MMA(0, 1, At, B1); PG8_BAR; PG8_SCHED;
            PG8_LDA(At, 0, 1); PG8_STAGE(PG8_SB(0, 0), b2, voffB); PG8_STAGE(PG8_SB(0, 1), b2 + hstep, voffB); PG8_STAGE(PG8_SA(0, 0), a2, voffA);
            PG8_WAIT_V(8); PG8_WAIT_L(0); PG8_BAR; PG8_MMA(1, 0, At, B0); PG8_MMA(1, 1, At, B1); PG8_BAR; PG8_SCHED;
            PG8_LDB(B0, 1, 0); PG8_LDB(B1, 1, 1); PG8_SCHED; PG8_LDA(At, 1, 0); PG8_STAGE(PG8_SA(0, 1), a2 + hstep, voffA);
            PG8_WAIT_V(8); PG8_WAIT_L(0); PG8_BAR; PG8_MMA(0, 0, At, B0); PG8_MMA(0, 1, At, B1); PG8_BAR; PG8_SCHED;
            PG8_LDA(At, 1, 1); PG8_STAGE(PG8_SB(1, 0), b3, voffB); PG8_STAGE(PG8_SB(1, 1), b3 + hstep, voffB); PG8_STAGE(PG8_SA(1, 0), a3, voffA);
            PG8_WAIT_V(8); PG8_WAIT_L(0); PG8_BAR; PG8_MMA(1, 0, At, B0); PG8_MMA(1, 1, At, B1); PG8_BAR; PG8_SCHED;
            } else {
            PG8_LDB(B0, 0, 0); PG8_SCHED; PG8_LDA(At, 0, 0); PG8_STAGE(PG8_SA(1, 1), a1 + hstep, voffA);
            PG8_WAIT_L(8); PG8_BAR; PG8_WAIT_L(0); PG8_MMA(0, 0, At, B0); PG8_BAR; PG8_SCHED;
            PG8_LDB(B1, 0, 1); PG8_STAGE(PG8_SB(0, 0), b2, voffB);
            PG8_BAR; PG8_WAIT_L(0); PG8_MMA(0, 1, At, B1); PG8_BAR;
            PG8_LDA(At, 0, 1); PG8_STAGE(PG8_SA(0, 0), a2, voffA);
            PG8_BAR; PG8_WAIT_L(0); PG8_MMA(1, 0, At, B0); PG8_BAR; PG8_SCHED;
            PG8_STAGE(PG8_SB(0, 1), b2 + hstep, voffB);
            PG8_WAIT_V(6); PG8_BAR; PG8_MMA(1, 1, At, B1); PG8_BAR;
            PG8_LDB(B0, 1, 0); PG8_SCHED; PG8_LDA(At, 1, 0); PG8_STAGE(PG8_SA(0, 1), a2 + hstep, voffA);
            PG8_WAIT_L(8); PG8_BAR; PG8_WAIT_L(0); PG8_MMA(0, 0, At, B0); PG8_BAR; PG8_SCHED;
            PG8_LDB(B1, 1, 1); PG8_STAGE(PG8_SB(1, 0), b3, voffB);
            PG8_BAR; PG8_WAIT_L(0); PG8_MMA(0, 1, At, B1); PG8_BAR;
            PG8_LDA(At, 1, 1); PG8_STAGE(PG8_SA(1, 0), a3, voffA);
            PG8_BAR; PG8_WAIT_L(0); PG8_MMA(1, 0, At, B0); PG8_BAR; PG8_SCHED;
            PG8_STAGE(PG8_SB(1, 1), b3 + hstep, voffB);
            PG8_WAIT_V(6); PG8_BAR; PG8_MMA(1, 1, At, B1); PG8_BAR;
            }
        }
        if constexpr (ALIGN_EPI) { if (wr == 0) PG8_BAR; }
        if constexpr (!Epi::AFTER_DRAIN) { E(acc, cur, wr, wc, fr, fq); S.done(cur); }
        if (!has_next) break;
#pragma unroll
        for (int a = 0; a < 2; ++a)
#pragma unroll
            for (int b = 0; b < 2; ++b)
#pragma unroll
                for (int m = 0; m < 4; ++m)
#pragma unroll
                    for (int n = 0; n < 2; ++n) acc[a][b][m][n] = (f32x4){0.f, 0.f, 0.f, 0.f};
        cur = nxt; cA = nA; cB = nB; ++ui;
        if constexpr (ALIGN_EPI) { if (wr == 1) PG8_BAR; }
    }
    PG8_WAIT_V(0);
    if constexpr (!ALIGN_EPI) { if (wr == 0) PG8_BAR; }
    PG8_BAR;
    if constexpr (Epi::AFTER_DRAIN) { E.fused(acc, cur, wr, wc, fr, fq, lds, wid, lane); S.done(cur); }
#undef PG8_SA
#undef PG8_SB
#undef PG8_STAGE
#undef PG8_LDA
#undef PG8_LDB
#undef PG8_MMA
#undef PG8_WAIT_V
#undef PG8_WAIT_L
#undef PG8_BAR
#undef PG8_SCHED
}
}

constexpr int D = 1024, MROWS = 16384, NCTX = 8192, FF = 2816, FF2 = 5632;
constexpr float EPS = 1e-6f;
constexpr float LOG2E = 1.4426950408889634f;

constexpr size_t MiB = 1u << 20;
constexpr size_t WS_MOD = 1 * MiB;
constexpr size_t WS_BUPP = 2 * MiB;
constexpr size_t WS_WQKV0 = 3 * MiB, WS_WQKV3 = 6 * MiB, WS_WQKV2 = 9 * MiB;
constexpr size_t WS_WO0 = 13 * MiB, WS_WO2 = 15 * MiB, WS_WO3 = 17 * MiB, WS_WGLU = 19 * MiB;
constexpr size_t WS_WUP = 23 * MiB;
constexpr size_t WS_WDN = 67 * MiB;
constexpr size_t WS_C0K = 89 * MiB, WS_C0V = 91 * MiB, WS_C2K = 93 * MiB, WS_C2V = 97 * MiB, WS_C3K = 101 * MiB, WS_C3V = 103 * MiB;
constexpr size_t WS_ABUF = 106 * MiB;
constexpr size_t WS_XN = 106 * MiB;
constexpr size_t WS_R = 194 * MiB;
constexpr size_t WS_H = WS_R;
constexpr size_t WS_QKV = WS_R;
constexpr size_t WS_QN = WS_R + 64 * MiB;
constexpr size_t WS_KN = WS_R + 96 * MiB;
constexpr size_t WS_OB = WS_R + 112 * MiB;
constexpr size_t WS_YTMP = WS_R;
constexpr size_t WS_GACT = WS_R + 64 * MiB;
constexpr size_t WS_END = 370 * MiB;

#define LAS __attribute__((address_space(3)))
typedef unsigned short bf16;
typedef short bf16x8 __attribute__((ext_vector_type(8)));
typedef short s16x4 __attribute__((ext_vector_type(4)));
typedef float f32x4 __attribute__((ext_vector_type(4)));
typedef float f32x16 __attribute__((ext_vector_type(16)));
typedef unsigned u32x4 __attribute__((ext_vector_type(4)));
typedef unsigned u32x2 __attribute__((ext_vector_type(2)));

__device__ __forceinline__ float bf2f(bf16 v) { return __uint_as_float(((unsigned)v) << 16); }
__device__ __forceinline__ unsigned pk2(float lo, float hi) { return pg8::cvt_pk_bf16(lo, hi); }
__device__ __forceinline__ bf16 f2bf(float v) { return (bf16)(pk2(v, 0.f) & 0xffffu); }
__device__ __forceinline__ float shfl_xor_l(float v, int o, int lane) { return __int_as_float(__builtin_amdgcn_ds_bpermute((lane ^ o) << 2, __float_as_int(v))); }
__device__ __forceinline__ float wave_sum(float v, int lane) {
#pragma unroll
    for (int o = 1; o < 64; o <<= 1) v += shfl_xor_l(v, o, lane);
    return v;
}
__device__ __forceinline__ float fast_sin(float x) { const float r = x * 0.15915494309189535f; return __builtin_amdgcn_sinf(r - floorf(r)); }
__device__ __forceinline__ float fast_cos(float x) { const float r = x * 0.15915494309189535f; return __builtin_amdgcn_cosf(r - floorf(r)); }
__device__ __forceinline__ float silu_f(float v) { return v / (1.0f + __expf(-v)); }
__device__ __forceinline__ float gelu_tanh(float v) {
    const float z = 0.7978845608028654f * (v + 0.044715f * v * v * v);
    const float t = 1.0f - 2.0f / (__expf(2.0f * z) + 1.0f);
    return 0.5f * v * (1.0f + t);
}

struct Args { const float* in[45]; int ph_lo, ph_hi; };
__device__ __forceinline__ const float* inp(const Args& a, int i) { asm volatile("" : "+s"(i)); return a.in[i]; }

__device__ __forceinline__ int map_row(int n0, int mode) {
    if (mode == 1) { const int bj = n0 / FF, r = n0 % FF; return 256 * (r / 128) + 128 * bj + (r % 128); }
    if (mode == 2) { const int bj = n0 / 1024, r = n0 % 1024; return 256 * (r / 128) + 128 * bj + (r % 128); }
    return n0;
}
__device__ __forceinline__ void transpose_item(const float* W, int K, int N, bf16* WT, int mode, LAS float* scr, int item, int lane) {
    const int nblk = N / 32, kb = item / nblk, nb = item % nblk, k0 = 64 * kb, n0 = 32 * nb;
    const int r0 = map_row(n0, mode);
#pragma unroll 8
    for (int i = 0; i < 32; ++i) { const int kk = 2 * i + (lane >> 5); scr[kk * 33 + (lane & 31)] = W[(size_t)(k0 + kk) * N + n0 + (lane & 31)]; }
    asm volatile("s_waitcnt lgkmcnt(0)" ::: "memory"); __builtin_amdgcn_wave_barrier();
    const int c = lane & 7;
#pragma unroll
    for (int j = 0; j < 4; ++j) { const int n = (lane >> 3) + 8 * j; const LAS float* s = scr + (8 * c) * 33 + n;
        u32x4 o; o.x = pk2(s[0 * 33], s[1 * 33]); o.y = pk2(s[2 * 33], s[3 * 33]); o.z = pk2(s[4 * 33], s[5 * 33]); o.w = pk2(s[6 * 33], s[7 * 33]);
        *(u32x4*)(WT + (size_t)(r0 + n) * K + k0 + 8 * c) = o; }
    asm volatile("s_waitcnt lgkmcnt(0)" ::: "memory"); __builtin_amdgcn_wave_barrier();
}
__device__ __forceinline__ void prologue_phase(const Args& a, LAS unsigned char* lds, int tid, int wave, int lane) {
    unsigned char* ws = (unsigned char*)inp(a, 44);
    float* outp = (float*)inp(a, 43);
    const int G = gridDim.x, bx = blockIdx.x;
    {
        LAS float* sc = (LAS float*)lds;
        LAS float* red = (LAS float*)(lds + 36864);
        for (int i = tid; i < 9 * 1024; i += 512) { const int ci = i >> 10, k = i & 1023; const float v = ci < 8 ? inp(a, 9)[ci * 1024 + k] : inp(a, 10)[k]; sc[i] = silu_f(v); }
        __syncthreads();
        float* mod = (float*)(ws + WS_MOD);
        for (int u = bx; u < 4 * 96; u += G) {
            const int l = u / 96, c0 = (u % 96) * 64;
            const float* w = inp(a, 13) + (size_t)l * 1024 * 6144 + c0 + lane;
            float acc[9];
#pragma unroll
            for (int i = 0; i < 9; ++i) acc[i] = 0.f;
            const int kb = wave * 128;
#pragma unroll 4
            for (int k = 0; k < 128; ++k) { const float wv = w[(size_t)(kb + k) * 6144];
#pragma unroll
                for (int i = 0; i < 9; ++i) acc[i] += sc[i * 1024 + kb + k] * wv; }
#pragma unroll
            for (int i = 0; i < 9; ++i) red[(wave * 9 + i) * 64 + lane] = acc[i];
            __syncthreads();
            for (int o = tid; o < 9 * 64; o += 512) { const int i = o >> 6, cc = o & 63; float s = inp(a, 14)[l * 6144 + c0 + cc];
#pragma unroll
                for (int w8 = 0; w8 < 8; ++w8) s += red[(w8 * 9 + i) * 64 + cc];
                mod[((size_t)l * 9 + i) * 6144 + c0 + cc] = s; }
            __syncthreads();
        }
    }
    __syncthreads();
    {
        LAS float* scr = (LAS float*)(lds + wave * 16384);
        const int gw = bx * 8 + wave, NGW = G * 8;
        constexpr int I_QA = 16 * 48, I_QC = 16 * 64, I_O = 16 * 32, I_G = 16 * 64, I_UP = 16 * 176, I_DN = 44 * 32;
        constexpr int NITEMS = 2 * I_QA + I_QC + 3 * I_O + I_G + 4 * I_UP + 4 * I_DN;
        for (int it = gw; it < NITEMS; it += NGW) {
            int r = it;
            if (r < I_QA) { transpose_item(inp(a, 20), 1024, 1536, (bf16*)(ws + WS_WQKV0), 0, scr, r, lane); continue; } r -= I_QA;
            if (r < I_QA) { transpose_item(inp(a, 38), 1024, 1536, (bf16*)(ws + WS_WQKV3), 0, scr, r, lane); continue; } r -= I_QA;
            if (r < I_QC) { transpose_item(inp(a, 34), 1024, 2048, (bf16*)(ws + WS_WQKV2), 0, scr, r, lane); continue; } r -= I_QC;
            if (r < I_O) { transpose_item(inp(a, 24), 1024, 1024, (bf16*)(ws + WS_WO0), 0, scr, r, lane); continue; } r -= I_O;
            if (r < I_O) { transpose_item(inp(a, 37), 1024, 1024, (bf16*)(ws + WS_WO2), 0, scr, r, lane); continue; } r -= I_O;
            if (r < I_O) { transpose_item(inp(a, 42), 1024, 1024, (bf16*)(ws + WS_WO3), 0, scr, r, lane); continue; } r -= I_O;
            if (r < I_G) { transpose_item(inp(a, 33), 1024, 2048, (bf16*)(ws + WS_WGLU), 2, scr, r, lane); continue; } r -= I_G;
            if (r < 4 * I_UP) { const int l = r / I_UP; transpose_item(inp(a, 15) + (size_t)l * 1024 * FF2, 1024, FF2, (bf16*)(ws + WS_WUP) + (size_t)l * FF2 * 1024, 1, scr, r % I_UP, lane); continue; } r -= 4 * I_UP;
            { const int l = r / I_DN; transpose_item(inp(a, 19) + (size_t)l * FF * 1024, FF, 1024, (bf16*)(ws + WS_WDN) + (size_t)l * 1024 * FF, 0, scr, r % I_DN, lane); }
        }
    }
    const size_t gt = (size_t)bx * 512 + tid, NT = (size_t)G * 512;
    for (size_t i = gt; i < (size_t)MROWS * D / 4; i += NT) {
        const size_t half = (size_t)NCTX * D / 4;
        const f32x4 v = i < half ? ((const f32x4*)inp(a, 0))[i] : ((const f32x4*)inp(a, 1))[i - half];
        ((f32x4*)outp)[i] = v;
    }
    {
        const int srcs[6] = {2, 3, 5, 6, 7, 8};
        const size_t dsts[6] = {WS_C0K, WS_C0V, WS_C2K, WS_C2V, WS_C3K, WS_C3V};
        const size_t cnt[6] = {1048576, 1048576, 2097152, 2097152, 1048576, 1048576};
#pragma unroll
        for (int s = 0; s < 6; ++s) {
            const f32x4* src = (const f32x4*)inp(a, srcs[s]); u32x2* dst = (u32x2*)(ws + dsts[s]);
            for (size_t i = gt; i < cnt[s] / 4; i += NT) { const f32x4 v = src[i]; u32x2 o; o.x = pk2(v[0], v[1]); o.y = pk2(v[2], v[3]); dst[i] = o; }
        }
    }
    {
        float* bp = (float*)(ws + WS_BUPP);
        for (size_t i = gt; i < 4 * FF2; i += NT) { const int l = (int)(i / FF2), gc = (int)(i % FF2); const int pn = gc / 256, bj = (gc % 256) / 128, cc = gc % 128;
            bp[i] = inp(a, 16)[l * FF2 + bj * FF + pn * 128 + cc]; }
    }
}

__device__ __forceinline__ void norm_phase(const float* x, const float* gain, const float* mod, int shoff, int scoff, bf16* xn, int wave, int lane) {
    const int gw = blockIdx.x * 8 + wave, NGW = gridDim.x * 8;
    for (int row = gw; row < MROWS; row += NGW) {
        const int ci = row < NCTX ? 8 : ((row - NCTX) >> 10);
        const f32x4* xr = (const f32x4*)(x + (size_t)row * D) + lane;
        f32x4 v[4]; float s = 0.f;
#pragma unroll
        for (int j = 0; j < 4; ++j) { v[j] = xr[64 * j]; s += (v[j][0] * v[j][0] + v[j][1] * v[j][1]) + (v[j][2] * v[j][2] + v[j][3] * v[j][3]); }
        const float rstd = rsqrtf(wave_sum(s, lane) * (1.0f / D) + EPS);
        const float* mrow = mod + ci * 6144;
        u32x2* o8 = (u32x2*)(xn + (size_t)row * D) + lane;
#pragma unroll
        for (int j = 0; j < 4; ++j) {
            const int c = 4 * lane + 256 * j;
            const f32x4 g = *(const f32x4*)(gain + c), sh = *(const f32x4*)(mrow + shoff + c), sc = *(const f32x4*)(mrow + scoff + c);
            f32x4 y;
#pragma unroll
            for (int e = 0; e < 4; ++e) y[e] = (v[j][e] * rstd * g[e]) * (1.0f + sc[e]) + sh[e];
            u32x2 o; o.x = pk2(y[0], y[1]); o.y = pk2(y[2], y[3]); o8[64 * j] = o;
        }
    }
}

template <int DH>
__device__ __forceinline__ void qkprep_phase(const bf16* qkv, int NKV, const float* qg, const float* kg, bf16* qn, bf16* kn, float* outk, float* outv, int wave, int lane) {
    constexpr int LPH = DH / 2, HPI = 64 / LPH, QUARTER = DH / 4, NH = 1024 / DH;
    const int KW = NKV * DH, ldq = 1024 + 2 * KW;
    const int gw = blockIdx.x * 8 + wave, NGW = gridDim.x * 8;
    const float qscale = rsqrtf((float)DH) * LOG2E;
    const int pi = lane % LPH;
    const bool first = pi < QUARTER;
    const int fi = first ? pi : pi - QUARTER;
    const int d1 = first ? pi : DH / 2 + fi, d2 = d1 + QUARTER;
    const float freq = __builtin_amdgcn_exp2f(-(float)fi * (13.287712379549449f / (float)QUARTER));
    for (int row = gw; row < MROWS; row += NGW) {
        const bool lat = row >= NCTX;
        const int t = (row - NCTX) & 1023;
        const float pos = first ? (float)(t >> 6) : (float)(t & 63);
        float cs = 1.f, sn = 0.f;
        if (lat) { const float ang = pos * freq; cs = fast_cos(ang); sn = fast_sin(ang); }
        const bf16* src = qkv + (size_t)row * ldq;
        for (int hb = 0; hb < NH + NKV; hb += HPI) {
            const int head = hb + lane / LPH;
            const bool isk = head >= NH;
            const float x1 = bf2f(src[head * DH + d1]), x2 = bf2f(src[head * DH + d2]);
            float ss = x1 * x1 + x2 * x2;
#pragma unroll
            for (int o = 1; o < LPH; o <<= 1) ss += shfl_xor_l(ss, o, lane);
            const float rstd = rsqrtf(ss * (1.0f / DH) + EPS);
            const float* g = isk ? kg : qg;
            float y1 = x1 * rstd * g[d1], y2 = x2 * rstd * g[d2];
            if (!lat && isk) { float* ok = outk + (size_t)row * KW + (head - NH) * DH; ok[d1] = y1; ok[d2] = y2; }
            if (lat) { const float r1 = y1 * cs - y2 * sn, r2 = y1 * sn + y2 * cs; y1 = r1; y2 = r2; }
            if (!isk) { bf16* q = qn + (size_t)row * 1024 + head * DH; q[d1] = f2bf(y1 * qscale); q[d2] = f2bf(y2 * qscale); }
            else { bf16* k = kn + (size_t)row * KW + (head - NH) * DH; k[d1] = f2bf(y1); k[d2] = f2bf(y2); }
        }
        if (!lat) { const bf16* v = src + 1024 + KW; float* ov = outv + (size_t)row * KW;
            for (int j = lane; j < KW; j += 64) ov[j] = bf2f(v[j]); }
    }
}

template <int DH, bool WIN>
__device__ __forceinline__ void attn_phase(const bf16* qn, const bf16* kn, const bf16* qkv, const bf16* cK, const bf16* cV, const float* sink, bf16* ob,
                                           LAS unsigned char* lds, int tid, int wave, int lane) {
    constexpr int NH = 1024 / DH, NKV = 4, GQ = NH / NKV, KW = NKV * DH, ldq = 1024 + 2 * KW;
    constexpr int KSTR = DH * 2 + 16;
    constexpr int CPR = DH / 8;
    constexpr int NLD = 64 * CPR / 512;
    LAS unsigned char* Ks = lds;
    LAS unsigned char* Vs = lds + 64 * KSTR;
    const int r32 = lane & 31, hi = lane >> 5;
    const int n_lat = 8 * NH * 4, n_ctx = 32 * NH;
    for (int u = blockIdx.x; u < n_lat + n_ctx; u += gridDim.x) {
        const bool lat = u < n_lat;
        int b, h, q0, qrow0, ncache, kstart, ntl;
        if (lat) { b = u / (NH * 4); const int rem = u % (NH * 4); h = rem >> 2; q0 = (rem & 3) * 256; qrow0 = NCTX + b * 1024 + q0; ncache = 8;
            if (WIN) { kstart = q0 >= 128 ? q0 - 128 : 0; const int kend = q0 + 384 < 1024 ? q0 + 384 : 1024; ntl = (kend - kstart) >> 6; } else { kstart = 0; ntl = 16; } }
        else { const int uu = u - n_lat; b = uu / NH; h = uu % NH; q0 = 0; qrow0 = b * 256; ncache = 0; kstart = 0; ntl = 4; }
        const int kvh = h / GQ;
        const int krow0 = lat ? NCTX + b * 1024 : b * 256;
        const int nt = ncache + ntl;
        bf16x8 qf[DH / 16];
        { const bf16* qp = qn + (size_t)(qrow0 + wave * 32 + r32) * 1024 + h * DH + 8 * hi;
#pragma unroll
          for (int d0 = 0; d0 < DH / 16; ++d0) qf[d0] = *(const bf16x8*)(qp + 16 * d0); }
        float m, l;
        if (sink) { m = sink[h] * LOG2E; l = hi == 0 ? 1.f : 0.f; } else { m = -1e30f; l = 0.f; }
        f32x16 o[DH / 32];
#pragma unroll
        for (int db = 0; db < DH / 32; ++db)
#pragma unroll
            for (int r = 0; r < 16; ++r) o[db][r] = 0.f;
        const int qpos = q0 + wave * 32 + r32;
        u32x4 kreg[NLD], vreg[NLD];
        auto issue = [&](int t) {
            const bf16 *kp, *vp; size_t kpitch, vpitch;
            if (t < ncache) { kp = cK + ((size_t)(b * 512 + 64 * t) * NKV + kvh) * DH; vp = cV + ((size_t)(b * 512 + 64 * t) * NKV + kvh) * DH; kpitch = KW; vpitch = KW; }
            else { const int ks = kstart + 64 * (t - ncache); kp = kn + (size_t)(krow0 + ks) * KW + kvh * DH; vp = qkv + (size_t)(krow0 + ks) * ldq + 1024 + KW + kvh * DH; kpitch = KW; vpitch = ldq; }
#pragma unroll
            for (int i = 0; i < NLD; ++i) { const int c = tid + 512 * i, row = c / CPR, cc = c % CPR;
                kreg[i] = *(const u32x4*)(kp + (size_t)row * kpitch + cc * 8); vreg[i] = *(const u32x4*)(vp + (size_t)row * vpitch + cc * 8); }
        };
        issue(0);
        for (int t = 0; t < nt; ++t) {
            __syncthreads();
#pragma unroll
            for (int i = 0; i < NLD; ++i) { const int c = tid + 512 * i, row = c / CPR, cc = c % CPR;
                *(LAS u32x4*)(Ks + row * KSTR + cc * 16) = kreg[i]; *(LAS u32x4*)(Vs + row * KSTR + cc * 16) = vreg[i]; }
            __syncthreads();
            if (t + 1 < nt) issue(t + 1);
            const int kt0 = t < ncache ? -100000 : kstart + 64 * (t - ncache);
            bool active = true;
            if (WIN && lat && t >= ncache) { const int qw = q0 + wave * 32; if (kt0 + 63 < qw - 128 || kt0 > qw + 31 + 128) active = false; }
            if (active) {
                f32x16 p[2];
#pragma unroll
                for (int kh = 0; kh < 2; ++kh) {
#pragma unroll
                    for (int r = 0; r < 16; ++r) p[kh][r] = 0.f;
                    const LAS unsigned char* kb = Ks + (32 * kh + r32) * KSTR + 16 * hi;
#pragma unroll
                    for (int d0 = 0; d0 < DH / 16; ++d0) { const bf16x8 kf = *(const LAS bf16x8*)(kb + 32 * d0); p[kh] = __builtin_amdgcn_mfma_f32_32x32x16_bf16(kf, qf[d0], p[kh], 0, 0, 0); }
                }
                if (WIN && lat && t >= ncache) {
#pragma unroll
                    for (int kh = 0; kh < 2; ++kh)
#pragma unroll
                        for (int r = 0; r < 16; ++r) { const int kpos = kt0 + 32 * kh + (r & 3) + 8 * (r >> 2) + 4 * hi; const int dd = qpos - kpos; if (dd > 128 || dd < -128) p[kh][r] = -1e30f; }
                }
                float mx = p[0][0];
#pragma unroll
                for (int r = 1; r < 16; ++r) mx = fmaxf(mx, p[0][r]);
#pragma unroll
                for (int r = 0; r < 16; ++r) mx = fmaxf(mx, p[1][r]);
                mx = fmaxf(mx, shfl_xor_l(mx, 32, lane));
                const float mn = fmaxf(m, mx), sc = __builtin_amdgcn_exp2f(m - mn); m = mn;
                float ls = 0.f;
#pragma unroll
                for (int kh = 0; kh < 2; ++kh)
#pragma unroll
                    for (int r = 0; r < 16; ++r) { const float e = __builtin_amdgcn_exp2f(p[kh][r] - mn); p[kh][r] = e; ls += e; }
                l = l * sc + ls;
#pragma unroll
                for (int db = 0; db < DH / 32; ++db)
#pragma unroll
                    for (int r = 0; r < 16; ++r) o[db][r] *= sc;
                const int i16 = lane & 15, qq = i16 >> 2, pp = i16 & 3, blk = (lane >> 4) & 1;
#pragma unroll
                for (int kh = 0; kh < 2; ++kh)
#pragma unroll
                    for (int s2 = 0; s2 < 2; ++s2) {
                        u32x4 pw; pw.x = pk2(p[kh][8 * s2 + 0], p[kh][8 * s2 + 1]); pw.y = pk2(p[kh][8 * s2 + 2], p[kh][8 * s2 + 3]); pw.z = pk2(p[kh][8 * s2 + 4], p[kh][8 * s2 + 5]); pw.w = pk2(p[kh][8 * s2 + 6], p[kh][8 * s2 + 7]);
                        const bf16x8 pf = __builtin_bit_cast(bf16x8, pw);
                        const LAS unsigned char* vb = Vs + (32 * kh + 16 * s2 + 4 * hi + qq) * KSTR + 32 * blk + 8 * pp;
#pragma unroll
                        for (int db = 0; db < DH / 32; ++db) {
                            const s16x4 lo = __builtin_bit_cast(s16x4, __builtin_amdgcn_ds_read_tr16_b64_v4i16((LAS s16x4*)(vb + 64 * db)));
                            const s16x4 hh = __builtin_bit_cast(s16x4, __builtin_amdgcn_ds_read_tr16_b64_v4i16((LAS s16x4*)(vb + 64 * db + 8 * KSTR)));
                            const bf16x8 vf = __builtin_shufflevector(lo, hh, 0, 1, 2, 3, 4, 5, 6, 7);
                            o[db] = __builtin_amdgcn_mfma_f32_32x32x16_bf16(vf, pf, o[db], 0, 0, 0);
                        }
                    }
            }
        }
        l += shfl_xor_l(l, 32, lane);
        const float rl = 1.0f / l;
        bf16* op = ob + (size_t)(qrow0 + wave * 32 + r32) * 1024 + h * DH + 4 * hi;
#pragma unroll
        for (int db = 0; db < DH / 32; ++db)
#pragma unroll
            for (int g4 = 0; g4 < 4; ++g4) { u32x2 w; w.x = pk2(o[db][4 * g4] * rl, o[db][4 * g4 + 1] * rl); w.y = pk2(o[db][4 * g4 + 2] * rl, o[db][4 * g4 + 3] * rl);
                *(u32x2*)(op + 32 * db + 8 * g4) = w; }
        __syncthreads();
    }
}

__device__ __forceinline__ void s5_phase(const Args& a, LAS unsigned char* lds, int wave, int lane) {
    constexpr int BU_STR = 132, H_STR = 136, WBYTES = 13056;
    LAS float* Bu = (LAS float*)(lds + wave * WBYTES);
    LAS bf16* Hs = (LAS bf16*)(lds + wave * WBYTES + 16 * BU_STR * 4);
    unsigned char* ws = (unsigned char*)inp(a, 44);
    const bf16* xn = (const bf16*)(ws + WS_XN);
    float* ytmp = (float*)(ws + WS_YTMP);
    bf16* gact = (bf16*)(ws + WS_GACT);
    const float *lam_re = inp(a, 25), *lam_im = inp(a, 26), *log_dt = inp(a, 27), *b_re = inp(a, 28), *b_im = inp(a, 29), *c_re = inp(a, 30), *c_im = inp(a, 31), *dskip = inp(a, 32);
    float* st_out = (float*)inp(a, 43) + 2 * (size_t)NCTX * D + 2 * 2097152;
    const int G = gridDim.x, gw = wave * G + blockIdx.x, NW = 8 * G;
    const int n16 = lane & 15, kq = lane >> 4;
    for (int u = gw; u < 2560; u += NW) {
        const bool lat = u < 512;
        const int seq = lat ? (u >> 6) : ((u - 512) >> 6), g = u & 63;
        const int S = lat ? 1024 : 256, row0 = lat ? NCTX + seq * 1024 : seq * 256;
        const float dsk = dskip[16 * g + n16];
#pragma unroll 1
        for (int dir = 0; dir < 2; ++dir) {
            const int gb = (dir * 64 + g);
            const float dt = __expf(log_dt[gb]);
            float ar, ai;
            { const float lr = lam_re[gb * 64 + lane], li = lam_im[gb * 64 + lane]; const float mag = __expf(lr * dt); ar = mag * fast_cos(li * dt); ai = mag * fast_sin(li * dt); }
            bf16x8 bfr[8], cfr[4];
#pragma unroll
            for (int nt = 0; nt < 8; ++nt) {
                const int j = 16 * nt + n16, pp = j & 63; const bool im = j >= 64;
                const float lr = lam_re[gb * 64 + pp], li = lam_im[gb * 64 + pp]; const float mag = __expf(lr * dt);
                const float are = mag * fast_cos(li * dt), aim = mag * fast_sin(li * dt), den = lr * lr + li * li, nre = are - 1.0f;
                const float fre = (nre * lr + aim * li) / den, fim = (aim * lr - nre * li) / den;
                u32x4 w = {0u, 0u, 0u, 0u};
                if (kq < 2) {
                    const float* br = b_re + ((size_t)gb * 64 + pp) * 16 + 8 * kq; const float* bi = b_im + ((size_t)gb * 64 + pp) * 16 + 8 * kq;
                    float v[8];
#pragma unroll
                    for (int i = 0; i < 8; ++i) v[i] = im ? (fre * bi[i] + fim * br[i]) : (fre * br[i] - fim * bi[i]);
                    w.x = pk2(v[0], v[1]); w.y = pk2(v[2], v[3]); w.z = pk2(v[4], v[5]); w.w = pk2(v[6], v[7]);
                }
                bfr[nt] = __builtin_bit_cast(bf16x8, w);
            }
#pragma unroll
            for (int ks = 0; ks < 4; ++ks) {
                const int k0 = 32 * ks + 8 * kq;
                float v[8];
#pragma unroll
                for (int i = 0; i < 8; ++i) { const int k = k0 + i; v[i] = k < 64 ? c_re[((size_t)gb * 16 + n16) * 64 + k] : -c_im[((size_t)gb * 16 + n16) * 64 + (k - 64)]; }
                u32x4 w; w.x = pk2(v[0], v[1]); w.y = pk2(v[2], v[3]); w.z = pk2(v[4], v[5]); w.w = pk2(v[6], v[7]);
                cfr[ks] = __builtin_bit_cast(bf16x8, w);
            }
            float hr = 0.f, hi_ = 0.f;
            if (lat) { const float* s0 = inp(a, 4) + ((size_t)(seq * 2 + dir) * 2) * 4096 + g * 64 + lane; hr = s0[0]; hi_ = s0[4096]; }
            const int nch = S / 16;
            const bf16* xa = xn + (size_t)row0 * D + 16 * g;
            auto ld_af = [&](int ch) -> u32x4 { const int t0 = dir == 0 ? ch * 16 : S - 16 - ch * 16; u32x4 r = {0u, 0u, 0u, 0u}; if (kq < 2) r = *(const u32x4*)(xa + (size_t)(t0 + n16) * D + 8 * kq); return r; };
            u32x4 afn = ld_af(0);
#pragma unroll 1
            for (int ch = 0; ch < nch; ++ch) {
                const int t0 = dir == 0 ? ch * 16 : S - 16 - ch * 16;
                const bf16x8 af = __builtin_bit_cast(bf16x8, afn);
                if (ch + 1 < nch) afn = ld_af(ch + 1);
                float yt[4], us[4];
                if (dir == 1) {
#pragma unroll
                    for (int i = 0; i < 4; ++i) { const size_t off = (size_t)(row0 + t0 + 4 * kq + i) * D + 16 * g + n16; yt[i] = ytmp[off]; us[i] = bf2f(xn[off]); }
                }
#pragma unroll
                for (int nt = 0; nt < 8; ++nt) {
                    f32x4 acc = {0.f, 0.f, 0.f, 0.f};
                    acc = __builtin_amdgcn_mfma_f32_16x16x32_bf16(af, bfr[nt], acc, 0, 0, 0);
#pragma unroll
                    for (int i = 0; i < 4; ++i) Bu[(4 * kq + i) * BU_STR + 16 * nt + n16] = acc[i];
                }
                asm volatile("s_waitcnt lgkmcnt(0)" ::: "memory"); __builtin_amdgcn_wave_barrier();
#pragma unroll
                for (int s = 0; s < 16; ++s) {
                    const int tt = dir == 0 ? s : 15 - s;
                    const float br = Bu[tt * BU_STR + lane], bi = Bu[tt * BU_STR + 64 + lane];
                    const float nr = ar * hr - ai * hi_ + br, ni = ar * hi_ + ai * hr + bi;
                    hr = nr; hi_ = ni;
                    Hs[tt * H_STR + lane] = f2bf(hr); Hs[tt * H_STR + 64 + lane] = f2bf(hi_);
                }
                asm volatile("s_waitcnt lgkmcnt(0)" ::: "memory"); __builtin_amdgcn_wave_barrier();
                f32x4 y = {0.f, 0.f, 0.f, 0.f};
#pragma unroll
                for (int ks = 0; ks < 4; ++ks) { const bf16x8 hf = *(const LAS bf16x8*)(Hs + n16 * H_STR + 32 * ks + 8 * kq); y = __builtin_amdgcn_mfma_f32_16x16x32_bf16(hf, cfr[ks], y, 0, 0, 0); }
                asm volatile("s_waitcnt lgkmcnt(0)" ::: "memory"); __builtin_amdgcn_wave_barrier();
#pragma unroll
                for (int i = 0; i < 4; ++i) {
                    const size_t off = (size_t)(row0 + t0 + 4 * kq + i) * D + 16 * g + n16;
                    if (dir == 0) ytmp[off] = y[i];
                    else gact[off] = f2bf(gelu_tanh(yt[i] + y[i] + us[i] * dsk));
                }
            }
            if (!lat) { float* so = st_out + ((size_t)(seq * 2 + dir) * 2) * 4096 + g * 64 + lane; so[0] = hr; so[4096] = hi_; }
        }
    }
}

__device__ __forceinline__ void conv_phase(const bf16* h, const float* ck, const float* cb, bf16* abuf, int tid) {
    const size_t NT = (size_t)gridDim.x * 512;
    for (size_t task = (size_t)blockIdx.x * 512 + tid; task < (size_t)352 * 1024; task += NT) {
        const int cgp = (int)(task % 352), rc = (int)(task / 352);
        const int j0 = cgp * 8, pn = j0 >> 7, jj = j0 & 127, hcol = 256 * pn + jj;
        const int r0 = rc * 16, L = r0 < NCTX ? 256 : 1024;
        const bool pv = (r0 % L) != 0, nv = ((r0 + 16) % L) != 0;
        float k0g[8], k1g[8], k2g[8], bg[8], k0v[8], k1v[8], k2v[8], bv[8];
#pragma unroll
        for (int e = 0; e < 8; ++e) { k0g[e] = ck[j0 + e]; k1g[e] = ck[FF2 + j0 + e]; k2g[e] = ck[2 * FF2 + j0 + e]; bg[e] = cb[j0 + e];
            k0v[e] = ck[FF + j0 + e]; k1v[e] = ck[FF2 + FF + j0 + e]; k2v[e] = ck[2 * FF2 + FF + j0 + e]; bv[e] = cb[FF + j0 + e]; }
        const bf16* hp = h + (size_t)r0 * FF2 + hcol;
        const u32x4 z = {0u, 0u, 0u, 0u};
        u32x4 gp = pv ? *(const u32x4*)(hp - FF2) : z, vp = pv ? *(const u32x4*)(hp - FF2 + 128) : z;
        u32x4 gc = *(const u32x4*)(hp), vc = *(const u32x4*)(hp + 128);
#pragma unroll 4
        for (int i = 0; i < 16; ++i) {
            const bool has = (i < 15) || nv;
            const u32x4 gn = has ? *(const u32x4*)(hp + (size_t)(i + 1) * FF2) : z, vn = has ? *(const u32x4*)(hp + (size_t)(i + 1) * FF2 + 128) : z;
            float o[8];
#pragma unroll
            for (int e = 0; e < 8; ++e) {
                const float a0 = __uint_as_float((e & 1) ? (gp[e >> 1] & 0xffff0000u) : (gp[e >> 1] << 16));
                const float a1 = __uint_as_float((e & 1) ? (gc[e >> 1] & 0xffff0000u) : (gc[e >> 1] << 16));
                const float a2 = __uint_as_float((e & 1) ? (gn[e >> 1] & 0xffff0000u) : (gn[e >> 1] << 16));
                const float b0 = __uint_as_float((e & 1) ? (vp[e >> 1] & 0xffff0000u) : (vp[e >> 1] << 16));
                const float b1 = __uint_as_float((e & 1) ? (vc[e >> 1] & 0xffff0000u) : (vc[e >> 1] << 16));
                const float b2 = __uint_as_float((e & 1) ? (vn[e >> 1] & 0xffff0000u) : (vn[e >> 1] << 16));
                const float gt = bg[e] + k0g[e] * a0 + k1g[e] * a1 + k2g[e] * a2;
                const float vl = bv[e] + k0v[e] * b0 + k1v[e] * b1 + k2v[e] * b2;
                o[e] = silu_f(gt) * vl;
            }
            u32x4 w; w.x = pk2(o[0], o[1]); w.y = pk2(o[2], o[3]); w.z = pk2(o[4], o[5]); w.w = pk2(o[6], o[7]);
            *(u32x4*)(abuf + (size_t)(r0 + i) * FF + j0) = w;
            gp = gc; vp = vc; gc = gn; vc = vn;
        }
    }
}

#define XB_TMO      128
#define XB_XCNT(j)  (256  + 64 * (j))
#define XB_XSUB(j)  (1280 + 64 * (j))
#define XB_XGEN(j)  (2304 + 64 * (j))
#define XB_TOP      3328
#define XB_TOPGEN   3392
#define XCD_BAR_WORDS 3456
#define XB_SPIN_CAP (1u << 18)

__device__ __forceinline__ unsigned xb_ld(unsigned* p)              { return __hip_atomic_load(p, __ATOMIC_RELAXED, __HIP_MEMORY_SCOPE_AGENT); }
__device__ __forceinline__ unsigned xb_add(unsigned* p, unsigned v) { return __hip_atomic_fetch_add(p, v, __ATOMIC_RELAXED, __HIP_MEMORY_SCOPE_AGENT); }
__device__ __forceinline__ unsigned xb_xcc_id() { return (unsigned)__builtin_amdgcn_s_getreg((3 << 11) | 20) & 0xFu; }
#define XB_SPIN(cond, bar) do { unsigned _sp = 0; while (cond) { __builtin_amdgcn_s_sleep(1); \
    if ((++_sp & 255u) == 0u) { if (xb_ld(&(bar)[XB_TMO])) break; if (_sp > XB_SPIN_CAP) { atomicAdd(&(bar)[XB_TMO], 1u); break; } } } } while (0)

struct XcdBarrier {
    unsigned* bar; unsigned x;
    volatile LAS unsigned* st;
};

__device__ __forceinline__ XcdBarrier xcd_barrier_post(unsigned* bar, volatile LAS unsigned* st) {
    XcdBarrier b; b.bar = bar; b.x = xb_xcc_id(); b.st = st;
    if (threadIdx.x == 0) (void)xb_add(&bar[XB_XCNT(b.x)], 1u);
    return b;
}
__device__ __forceinline__ void xcd_barrier_complete(unsigned* bar, unsigned x, unsigned& nloc, unsigned& nx) {
    const unsigned G = gridDim.x * gridDim.y * gridDim.z;
    unsigned sum, cnt, mine, sp = 0u;
    for (;;) {
        sum = 0u; cnt = 0u; mine = 0u;
#pragma unroll
        for (unsigned j = 0; j < 16; ++j) { const unsigned c = xb_ld(&bar[XB_XCNT(j)]); sum += c; cnt += (c > 0u) ? 1u : 0u; mine = (j == x) ? c : mine; }
        if (sum == G) break;
        __builtin_amdgcn_s_sleep(1);
        if ((++sp & 255u) == 0u) { if (xb_ld(&bar[XB_TMO])) break; if (sp > XB_SPIN_CAP) { atomicAdd(&bar[XB_TMO], 1u); break; } }
    }
    nloc = mine > 0u ? mine : 1u; nx = cnt > 0u ? cnt : 1u;
}

__device__ __forceinline__ void xcd_barrier(const XcdBarrier& b) {
    asm volatile("s_waitcnt vmcnt(0)" ::: "memory");
    __syncthreads();
    if (threadIdx.x == 0) {
        unsigned* bar = b.bar;
        __builtin_amdgcn_s_waitcnt(0);
        unsigned nloc = b.st[0], nx = b.st[1];
        if (nloc == 0u) { xcd_barrier_complete(bar, b.x, nloc, nx); b.st[0] = nloc; b.st[1] = nx; }
        const unsigned old = xb_add(&bar[XB_XSUB(b.x)], 1u);
        const unsigned gen = old / nloc;
        if (old + 1u == (gen + 1u) * nloc) {
            __builtin_amdgcn_fence(__ATOMIC_RELEASE, "agent");
            asm volatile("s_waitcnt vmcnt(0)" ::: "memory");
            const unsigned og = xb_add(&bar[XB_TOP], 1u);
            const unsigned tg = og / nx;
            if (og + 1u == (tg + 1u) * nx) xb_add(&bar[XB_TOPGEN], 1u);
            else XB_SPIN(xb_ld(&bar[XB_TOPGEN]) == tg, bar);
            __builtin_amdgcn_fence(__ATOMIC_ACQUIRE, "agent");
            xb_add(&bar[XB_XGEN(b.x)], 1u);
            asm volatile("s_waitcnt vmcnt(0)" ::: "memory");
        } else {
            XB_SPIN(xb_ld(&bar[XB_XGEN(b.x)]) == gen, bar);
            __builtin_amdgcn_fence(__ATOMIC_ACQUIRE, "agent");
            asm volatile("s_waitcnt vmcnt(0)" ::: "memory");
        }
    }
    __syncthreads();
}

constexpr int LDS_BYTES = 147456;
constexpr int NPHASE = 37;
__global__ void __launch_bounds__(512, 2) hybrid_fwd(Args a) {
    extern __shared__ __attribute__((aligned(16))) unsigned char lds_raw[];
    LAS unsigned char* lds = (LAS unsigned char*)lds_raw;
    cg::grid_group grid = cg::this_grid();
    if (a.ph_lo < 0) grid.sync();
    { volatile LAS unsigned* m = (volatile LAS unsigned*)(lds + 131072); if (threadIdx.x < 16) m[threadIdx.x] = 0u; }
    __syncthreads();
    XcdBarrier bar = xcd_barrier_post((unsigned*)inp(a, 44), (volatile LAS unsigned*)(lds + 131072) + 8);
    bool first = true;
    for (int idx = a.ph_lo; idx < a.ph_hi; ++idx) {
        int ph = idx;
        if (PROBE_DUP >= 0 && idx > PROBE_DUP) ph = idx - 1;
        int tid = threadIdx.x; asm volatile("" : "+v"(tid));
        const int lane = tid & 63, wave = __builtin_amdgcn_readfirstlane(tid >> 6);
        unsigned char* ws = (unsigned char*)inp(a, 44);
        float* x = (float*)inp(a, 43);
        bf16* xn = (bf16*)(ws + WS_XN);
        const int l = (ph - 1) / 9, sub = (ph - 1) % 9;
        if (ph > 0 && l == 1 && (sub == 3 || sub == 4)) continue;
        if (!first) xcd_barrier(bar);
        first = false;
        #ifndef NO_PRO
        if (ph == 0) { prologue_phase(a, lds, tid, wave, lane); continue; }
#endif
        const float* mod = (const float*)(ws + WS_MOD) + (size_t)l * 9 * 6144;
        const int kind = (l == 1) ? 1 : (l == 2 ? 2 : 0);
        const int nqkv = kind == 2 ? 2048 : 1536;
        bf16* qkv = (bf16*)(ws + WS_QKV); bf16* qn = (bf16*)(ws + WS_QN); bf16* kn = (bf16*)(ws + WS_KN); bf16* ob = (bf16*)(ws + WS_OB);
#ifndef NO_NORM
        if (sub == 0) { norm_phase(x, inp(a, 11) + l * D, mod, 0, 1024, xn, wave, lane); continue; }
        if (sub == 5) { norm_phase(x, inp(a, 12) + l * D, mod, 3072, 4096, xn, wave, lane); continue; }
#endif
#ifndef NO_GEMM
        {
            const bool isg = (sub == 1 && kind != 1) || sub == 6 || (sub == 4 && kind != 1) || sub == 8 || (sub == 2 && kind == 1);
            if (isg) {
                pg8::Gemm g; pg8::EpiMulti E;
                E.e0 = pg8::EpiBf16<0>{qkv, nqkv, nullptr, 0, 0, 1.f}; E.e1 = pg8::EpiResGate{x, mod, 2048}; E.e2 = pg8::EpiGlu{x, mod, 2048};
                if (sub == 1) { const bf16* wt = (const bf16*)(ws + (l == 0 ? WS_WQKV0 : (l == 2 ? WS_WQKV2 : WS_WQKV3))); g = pg8::Gemm{xn, wt, MROWS, nqkv, D}; E.mode = 0; }
                else if (sub == 6) { g = pg8::Gemm{xn, (const bf16*)(ws + WS_WUP) + (size_t)l * FF2 * 1024, MROWS, FF2, D}; E.mode = 0;
                    E.e0 = pg8::EpiBf16<0>{(bf16*)(ws + WS_H), FF2, (const float*)(ws + WS_BUPP) + l * FF2, 0, 0, 1.f}; }
                else if (sub == 4) { const bf16* wt = (const bf16*)(ws + (l == 0 ? WS_WO0 : (l == 2 ? WS_WO2 : WS_WO3))); g = pg8::Gemm{ob, wt, MROWS, D, D}; E.mode = 1; }
                else if (sub == 8) { g = pg8::Gemm{(const bf16*)(ws + WS_ABUF), (const bf16*)(ws + WS_WDN) + (size_t)l * 1024 * FF, MROWS, D, FF}; E.mode = 1; E.e1.goff = 5120; }
                else { g = pg8::Gemm{(const bf16*)(ws + WS_GACT), (const bf16*)(ws + WS_WGLU), MROWS, 2048, D}; E.mode = 2; }
                pg8::StaticOrder S; S.init(g.M, g.N, gridDim.x, (int)blockIdx.x);
                pg8::gemm_phase<pg8::EpiMulti, pg8::StaticOrder, true, true>(lds, g, S, E, tid);
                continue;
            }
        }
#endif
#ifndef NO_CONV
        if (sub == 7) { conv_phase((const bf16*)(ws + WS_H), inp(a, 17) + (size_t)l * 3 * FF2, inp(a, 18) + (size_t)l * FF2, (bf16*)(ws + WS_ABUF), tid); continue; }
#endif
        if (kind == 1) {
#ifndef NO_S5
            if (sub == 1) { s5_phase(a, lds, wave, lane); continue; }
#endif
            continue;
        }
        float* o_k = x + 2 * (size_t)NCTX * D + (l == 0 ? 0 : (l == 2 ? 2 * 2097152 + 524288 : 2 * 2097152 + 524288 + 2 * 4194304));
#ifndef NO_QKP
        if (sub == 2) {
            if (kind == 0) qkprep_phase<64>(qkv, 4, inp(a, l == 0 ? 21 : 39), inp(a, l == 0 ? 22 : 40), qn, kn, o_k, o_k + 2097152, wave, lane);
            else qkprep_phase<128>(qkv, 4, inp(a, 35), inp(a, 36), qn, kn, o_k, o_k + 4194304, wave, lane);
            continue;
        }
#endif
#ifndef NO_ATT
        if (sub == 3) {
            if (kind == 0) attn_phase<64, true>(qn, kn, qkv, (const bf16*)(ws + (l == 0 ? WS_C0K : WS_C3K)), (const bf16*)(ws + (l == 0 ? WS_C0V : WS_C3V)), inp(a, l == 0 ? 23 : 41), ob, lds, tid, wave, lane);
            else attn_phase<128, false>(qn, kn, qkv, (const bf16*)(ws + WS_C2K), (const bf16*)(ws + WS_C2V), nullptr, ob, lds, tid, wave, lane);
            continue;
        }
#endif
    }
}

extern "C" void kernel_launch(void* const* d_in, const int* in_sizes, int n_in, void* d_out, int out_size, void* d_ws, size_t ws_size, hipStream_t stream) {
    static int grid = 0;
    if (grid == 0) {
        if (n_in != 43 || ws_size < WS_END) { fprintf(stderr, "kernel_launch: unexpected n_in %d / ws_size %zu (need %zu)\n", n_in, ws_size, (size_t)WS_END); grid = -1; return; }
        int dev = 0, cus = 0, per_cu = 0;
        hipGetDevice(&dev);
        hipDeviceGetAttribute(&cus, hipDeviceAttributeMultiprocessorCount, dev);
        hipFuncSetAttribute((const void*)hybrid_fwd, hipFuncAttributeMaxDynamicSharedMemorySize, LDS_BYTES);
        hipOccupancyMaxActiveBlocksPerMultiprocessor(&per_cu, (const void*)hybrid_fwd, 512, LDS_BYTES);
        if (per_cu < 1) per_cu = 1;
        (void)hipGetLastError();
        grid = cus * per_cu;
        if (grid > 256) grid = 256;
    }
    if (grid < 0) return;
    if (hipMemsetAsync(d_ws, 0, 65536, stream) != hipSuccess) { fprintf(stderr, "kernel_launch: memset failed\n"); return; }
    Args a{};
    for (int i = 0; i < 43; ++i) a.in[i] = (const float*)d_in[i];
    a.in[43] = (const float*)d_out; a.in[44] = (const float*)d_ws;
#if ONE_LAUNCH
    a.ph_lo = 0; a.ph_hi = NPHASE + (PROBE_DUP >= 0 ? 1 : 0);
    void* kargs[] = {&a};
    hipError_t e = hipLaunchCooperativeKernel((const void*)hybrid_fwd, dim3(grid), dim3(512), kargs, LDS_BYTES, stream);
    if (e != hipSuccess) fprintf(stderr, "cooperative launch failed: %s (grid %d)\n", hipGetErrorString(e), grid);
#else
    for (int ph = 0; ph < NPHASE; ++ph) {
        const int l = (ph - 1) / 9, sub = (ph - 1) % 9;
        if (ph > 0 && l == 1 && (sub == 3 || sub == 4)) continue;
        a.ph_lo = ph; a.ph_hi = ph + 1;
        hipLaunchKernelGGL(hybrid_fwd, dim3(grid), dim3(512), LDS_BYTES, stream, a);
    }
#endif
}
```

```cpp
#include <hip/hip_runtime.h>
#include <hip/hip_cooperative_groups.h>
#include <cstdio>
#include <cstdint>
namespace cg = cooperative_groups;
#ifndef ONE_LAUNCH
#define ONE_LAUNCH 1
#endif
#ifndef PROBE_DUP
#define PROBE_DUP -1
#endif
namespace pg8 {
#define PG8_LAS __attribute__((address_space(3)))
typedef unsigned short bf16_t;
typedef short bf16x8 __attribute__((ext_vector_type(8)));
typedef float f32x4 __attribute__((ext_vector_type(4)));
typedef unsigned u32x4 __attribute__((ext_vector_type(4)));
constexpr int BM = 256, BK = 64, HALF = 128, HTB = HALF * BK * 2  , STAGE_BYTES = 8 * HTB, NXCD = 8, WGM = 8;

__host__ __device__ __forceinline__ int lds_byte(int r, int c) { const int st = (r >> 4) * 2 + (c >> 5), rr = r & 15, cc = c & 31, ob = rr * 64 + cc * 2; return st * 1024 + (ob ^ (((ob >> 9) & 1) << 5)); }
__host__ __device__ __forceinline__ void stage_rc(int b, int& R, int& C) { const int st = b / 1024, sb = b % 1024, swz = sb ^ (((sb >> 9) & 1) << 5); R = (st >> 1) * 16 + swz / 64; C = (st & 1) * 32 + (swz % 64) / 2; }
__host__ __device__ __forceinline__ int perm32(int rho) { const int n = rho >> 4, i = rho & 15; return 8 * (i >> 2) + 4 * n + (i & 3); }

struct Unit { int pm, pn; };
struct Gemm { const bf16_t* A; const bf16_t* Bt; int M, N, K; };

struct StaticOrder {
    int nM, nN, nwg, G, c;
    __host__ __device__ void init(int M, int N, int G_, int c_) { nM = M / BM; nN = N / BM; nwg = nM * nN; G = G_; c = c_; }
    __host__ __device__ bool next(int i, Unit& u) const {
        const long L = (long)i * G + c; if (L >= nwg) return false;
        int wgid = (int)L; { const int q = nwg / NXCD, r = nwg % NXCD, xcd = wgid % NXCD, off = wgid / NXCD; wgid = (xcd < r ? xcd * (q + 1) : r * (q + 1) + (xcd - r) * q) + off; }
        const int nig = WGM * nN, gid = wgid / nig, fm = gid * WGM, gsz = (nM - fm) < WGM ? (nM - fm) : WGM;
        u.pm = fm + ((wgid % nig) % gsz); u.pn = (wgid % nig) / gsz; return true;
    }
    __device__ __forceinline__ void a_ready(const Unit&) const {}
    __device__ __forceinline__ void done(const Unit&) const {}
};

typedef float f32x2c __attribute__((ext_vector_type(2))); typedef __bf16 bf16x2c __attribute__((ext_vector_type(2)));
__device__ __forceinline__ unsigned cvt_pk_bf16(float lo, float hi) { f32x2c v = {lo, hi}; bf16x2c b = __builtin_convertvector(v, bf16x2c); return __builtin_bit_cast(unsigned, b); }
typedef float f32x2 __attribute__((ext_vector_type(2)));
__device__ __forceinline__ f32x2 gelu_pk(f32x2 v) {
    const f32x2 av = __builtin_elementwise_abs(v), d = av * 0.2316418882f + 1.0f;
    f32x2 t; t.x = __builtin_amdgcn_rcpf(d.x); t.y = __builtin_amdgcn_rcpf(d.y);
    f32x2 q = t * 0.5307027145f + (-0.7265760135f); q = q * t + 0.7107068705f; q = q * t + (-0.142248368f); q = q * t + 0.127414796f; q = q * t;
    const f32x2 s = (v * v) * (-0.72134752044f);
    f32x2 e; e.x = __builtin_amdgcn_exp2f(s.x); e.y = __builtin_amdgcn_exp2f(s.y);
    const f32x2 m = v * (q * e), r = v - m;
    f32x2 o; o.x = v.x < 0.f ? m.x : r.x; o.y = v.y < 0.f ? m.y : r.y; return o;
}

template <int ACT  > struct EpiBf16 {
    static constexpr bool PERM = true, AFTER_DRAIN = false; static_assert(ACT == 0 || ACT == 1, "EpiBf16: ACT is 0 (none) or 1 (gelu_pk)");
    bf16_t* O; int ldc; const float* bias; int split_cols; size_t split_stride; float scale0;
    __device__ __forceinline__ void operator()(const f32x4 (&acc)[2][2][4][2], const Unit& u, int wr, int wc, int fr, int fq) const {
        const int row0 = u.pm * BM + wr * 64 + fr; int colt = u.pn * BM; bf16_t* base = O;
        float sc = 1.f; if (split_cols) { const int t = colt / split_cols; base += (size_t)t * split_stride; colt -= t * split_cols; if (t == 0) sc = scale0; }
        const int col0 = colt + wc * 32 + 8 * fq, bcol0 = u.pn * BM + wc * 32 + 8 * fq;
        f32x4 bv[2][2];
#pragma unroll
        for (int bj = 0; bj < 2; ++bj)
#pragma unroll
            for (int n = 0; n < 2; ++n) bv[bj][n] = bias ? *(const f32x4*)(bias + bcol0 + bj * HALF + 4 * n) : (f32x4){0.f, 0.f, 0.f, 0.f};
#pragma unroll
        for (int ai = 0; ai < 2; ++ai)
#pragma unroll
            for (int m = 0; m < 4; ++m) { bf16_t* rowp = base + (size_t)(row0 + ai * HALF + m * 16) * ldc + col0;
#pragma unroll
                for (int bj = 0; bj < 2; ++bj) { f32x4 v0 = acc[ai][bj][m][0] + bv[bj][0], v1 = acc[ai][bj][m][1] + bv[bj][1];
                    if (ACT == 1) { f32x2 a = gelu_pk((f32x2){v0[0], v0[1]}), b = gelu_pk((f32x2){v0[2], v0[3]}), c = gelu_pk((f32x2){v1[0], v1[1]}), d = gelu_pk((f32x2){v1[2], v1[3]});
                        v0 = (f32x4){a.x, a.y, b.x, b.y}; v1 = (f32x4){c.x, c.y, d.x, d.y}; }
                    v0 = v0 * sc; v1 = v1 * sc; u32x4 w; w.x = cvt_pk_bf16(v0[0], v0[1]); w.y = cvt_pk_bf16(v0[2], v0[3]); w.z = cvt_pk_bf16(v1[0], v1[1]); w.w = cvt_pk_bf16(v1[2], v1[3]);
                    *(u32x4*)(rowp + bj * HALF) = w; } }
    }
};
struct EpiResGate {
    static constexpr bool PERM = false, AFTER_DRAIN = false;
    float* x; const float* mod; int goff;
    __device__ __forceinline__ void operator()(const f32x4 (&acc)[2][2][4][2], const Unit& u, int wr, int wc, int fr, int fq) const {
        const int ci = u.pm < 32 ? 8 : ((u.pm - 32) >> 2);
        const float* g = mod + ci * 6144 + goff;
        const int col0 = u.pn * BM + wc * 32 + 4 * fq;
        f32x4 gv[2][2];
#pragma unroll
        for (int bj = 0; bj < 2; ++bj)
#pragma unroll
            for (int n = 0; n < 2; ++n) gv[bj][n] = *(const f32x4*)(g + col0 + bj * HALF + n * 16);
#pragma unroll
        for (int ai = 0; ai < 2; ++ai)
#pragma unroll
            for (int m = 0; m < 4; ++m) { float* xr = x + (size_t)(u.pm * BM + ai * HALF + wr * 64 + m * 16 + fr) * 1024 + col0;
#pragma unroll
                for (int bj = 0; bj < 2; ++bj)
#pragma unroll
                    for (int n = 0; n < 2; ++n) { f32x4 v = *(const f32x4*)(xr + bj * HALF + n * 16); v = v + gv[bj][n] * acc[ai][bj][m][n]; *(f32x4*)(xr + bj * HALF + n * 16) = v; }
                asm volatile("" ::: "memory"); }
    }
};
struct EpiGlu {
    static constexpr bool PERM = false, AFTER_DRAIN = false;
    float* x; const float* mod; int goff;
    __device__ __forceinline__ void operator()(const f32x4 (&acc)[2][2][4][2], const Unit& u, int wr, int wc, int fr, int fq) const {
        const int ci = u.pm < 32 ? 8 : ((u.pm - 32) >> 2);
        const float* g = mod + ci * 6144 + goff;
        const int col0 = u.pn * HALF + wc * 32 + 4 * fq;
        f32x4 gv[2];
#pragma unroll
        for (int n = 0; n < 2; ++n) gv[n] = *(const f32x4*)(g + col0 + n * 16);
#pragma unroll
        for (int ai = 0; ai < 2; ++ai)
#pragma unroll
            for (int m = 0; m < 4; ++m) { float* xr = x + (size_t)(u.pm * BM + ai * HALF + wr * 64 + m * 16 + fr) * 1024 + col0;
#pragma unroll
                for (int n = 0; n < 2; ++n) { const f32x4 h = acc[ai][0][m][n], hg = acc[ai][1][m][n]; f32x4 s;
#pragma unroll
                    for (int e = 0; e < 4; ++e) s[e] = h[e] / (1.0f + __expf(-hg[e]));
                    f32x4 v = *(const f32x4*)(xr + n * 16); v = v + gv[n] * s; *(f32x4*)(xr + n * 16) = v; }
                asm volatile("" ::: "memory"); }
    }
};

struct EpiMulti {
    static constexpr bool AFTER_DRAIN = false;
    int mode; EpiBf16<0> e0; EpiResGate e1; EpiGlu e2;
    __device__ __forceinline__ bool perm() const { return mode == 0; }
    __device__ __forceinline__ void operator()(const f32x4 (&acc)[2][2][4][2], const Unit& u, int wr, int wc, int fr, int fq) const {
        if (mode == 0) e0(acc, u, wr, wc, fr, fq); else if (mode == 1) e1(acc, u, wr, wc, fr, fq); else e2(acc, u, wr, wc, fr, fq);
    }
};
template <class Epi, class Sched, bool ALIGN_EPI = false, bool SP2 = false>
__device__ __forceinline__ void gemm_phase(PG8_LAS unsigned char* lds, const Gemm g, const Sched& S, const Epi& E, const int tid) {
    const int wid = __builtin_amdgcn_readfirstlane(tid >> 6), lane = tid & 63, wr = wid >> 2, wc = wid & 3, fr = lane & 15, fq = lane >> 4;
    const int K = g.K, nt = K / BK;
    unsigned voffA[2], voffB[2];
#pragma unroll
    for (int i = 0; i < 2; ++i) { int R, C; stage_rc(tid * 16 + i * 8192, R, C); const int Rb = E.perm() ? ((R & ~31) + perm32(R & 31)) : R;
        voffA[i] = (unsigned)(R * K + C) * 2u; voffB[i] = (unsigned)(Rb * K + C) * 2u; }
    const size_t kstep = (size_t)(BK * 2);
    const size_t hstep = (size_t)HALF * K * 2;
    const size_t tstep = 2 * hstep;
    const unsigned ldsw = (unsigned)wid * 1024u;
    const int aoff = lds_byte(wr * 64 + fr, fq * 8), boff = lds_byte(wc * 32 + fr, fq * 8);
#define PG8_SA(b, h) (((b) * 2 + (h)) * HTB)
#define PG8_SB(b, h) ((4 + (b) * 2 + (h)) * HTB)
#define PG8_STAGE(bufoff, gbase, voff) do { _Pragma("unroll") for (int _i = 0; _i < 2; ++_i) \
        __builtin_amdgcn_global_load_lds((const unsigned*)((const char*)(gbase) + (voff)[_i]), (PG8_LAS unsigned*)(lds + (bufoff) + ldsw + _i * 8192), 16, 0, 0); } while (0)
#define PG8_LDA(dst, b, h) do { _Pragma("unroll") for (int m = 0; m < 4; ++m) _Pragma("unroll") for (int k = 0; k < 2; ++k) dst[m][k] = *(const PG8_LAS bf16x8*)(lds + PG8_SA(b, h) + aoff + m * 2048 + k * 1024); } while (0)
#define PG8_LDB(dst, b, h) do { _Pragma("unroll") for (int n = 0; n < 2; ++n) _Pragma("unroll") for (int k = 0; k < 2; ++k) dst[n][k] = *(const PG8_LAS bf16x8*)(lds + PG8_SB(b, h) + boff + n * 2048 + k * 1024); } while (0)
#define PG8_MMA(ai, bj, At, Bt) do { __builtin_amdgcn_s_setprio(1); _Pragma("unroll") for (int m = 0; m < 4; ++m) _Pragma("unroll") for (int n = 0; n < 2; ++n) _Pragma("unroll") for (int k = 0; k < 2; ++k) \
        acc[ai][bj][m][n] = __builtin_amdgcn_mfma_f32_16x16x32_bf16(Bt[n][k], At[m][k], acc[ai][bj][m][n], 0, 0, 0); __builtin_amdgcn_s_setprio(0); } while (0)
#define PG8_WAIT_V(n) asm volatile("s_waitcnt vmcnt(" #n ")" ::: "memory")
#define PG8_WAIT_L(n) asm volatile("s_waitcnt lgkmcnt(" #n ")" ::: "memory")
#define PG8_BAR __builtin_amdgcn_s_barrier()
#define PG8_SCHED __builtin_amdgcn_sched_barrier(0)
    Unit cur, nxt; int ui = 0;
    if (!S.next(0, cur)) return;
    f32x4 acc[2][2][4][2];
#pragma unroll
    for (int a = 0; a < 2; ++a)
#pragma unroll
        for (int b = 0; b < 2; ++b)
#pragma unroll
            for (int m = 0; m < 4; ++m)
#pragma unroll
                for (int n = 0; n < 2; ++n) acc[a][b][m][n] = (f32x4){0.f, 0.f, 0.f, 0.f};
    bf16x8 At[4][2], B0[2][2], B1[2][2];
    const char* cA = (const char*)g.A + (size_t)cur.pm * tstep; const char* cB = (const char*)g.Bt + (size_t)cur.pn * tstep;
    S.a_ready(cur);
    if constexpr (SP2) {
        PG8_STAGE(PG8_SB(0, 0), cB, voffB); PG8_STAGE(PG8_SB(0, 1), cB + hstep, voffB); PG8_STAGE(PG8_SA(0, 0), cA, voffA); PG8_STAGE(PG8_SA(0, 1), cA + hstep, voffA);
        if (wr == 1) PG8_BAR;
        PG8_WAIT_V(2); PG8_BAR;
        PG8_STAGE(PG8_SB(1, 0), cB + kstep, voffB); PG8_STAGE(PG8_SA(1, 0), cA + kstep, voffA); PG8_STAGE(PG8_SB(1, 1), cB + hstep + kstep, voffB);
        PG8_WAIT_V(6); PG8_BAR;
    } else {
        PG8_STAGE(PG8_SB(0, 0), cB, voffB); PG8_STAGE(PG8_SA(0, 0), cA, voffA); PG8_STAGE(PG8_SB(0, 1), cB + hstep, voffB); PG8_STAGE(PG8_SA(0, 1), cA + hstep, voffA);
        if (wr == 1) PG8_BAR;
        PG8_WAIT_V(4); PG8_BAR;
        PG8_STAGE(PG8_SB(1, 0), cB + kstep, voffB); PG8_STAGE(PG8_SA(1, 0), cA + kstep, voffA); PG8_STAGE(PG8_SB(1, 1), cB + hstep + kstep, voffB);
        PG8_WAIT_V(6); PG8_BAR;
    }
    for (;;) {
        const bool has_next = S.next(ui + 1, nxt);
        const char* nA = has_next ? (const char*)g.A + (size_t)nxt.pm * tstep : cA; const char* nB = has_next ? (const char*)g.Bt + (size_t)nxt.pn * tstep : cB;
        for (int t = 0; t < nt; t += 2) {
            const bool last = (t == nt - 2);
            const char* a1 = cA + (size_t)(t + 1) * kstep;
            const char* a2 = last ? nA : cA + (size_t)(t + 2) * kstep; const char* b2 = last ? nB : cB + (size_t)(t + 2) * kstep;
            const char* a3 = a2 + kstep; const char* b3 = b2 + kstep;
            if (last && has_next) S.a_ready(nxt);
            if constexpr (SP2) {
            PG8_LDB(B0, 0, 0); PG8_LDB(B1, 0, 1); PG8_SCHED; PG8_LDA(At, 0, 0); PG8_STAGE(PG8_SA(1, 1), a1 + hstep, voffA);
            PG8_WAIT_V(8); PG8_WAIT_L(0); PG8_BAR; PG8_MMA(0, 0, At, B0); PG8_MMA(0, 1, At, B1); PG8_BAR; PG8_SCHED;
            PG8_LDA(At, 0, 1); PG8_STAGE(PG8_SB(0, 0), b2, voffB); PG8_STAGE(PG8_SB(0, 1), b2 + hstep, voffB); PG8_STAGE(PG8_SA(0, 0), a2, voffA);
            PG8_WAIT_V(8); PG8_WAIT_L(0); PG8_BAR; PG8_MMA(1, 0, At, B0); PG8_MMA(1, 1, At, B1); PG8_BAR; PG8_SCHED;
            PG8_LDB(B0, 1, 0); PG8_LDB(B1, 1, 1); PG8_SCHED; PG8_LDA(At, 1, 0); PG8_STAGE(PG8_SA(0, 1), a2 + hstep, voffA);
            PG8_WAIT_V(8); PG8_WAIT_L(0); PG8_BAR; PG8_MMA(0, 0, At, B0); PG8_MMA(0, 1, At, B1); PG8_BAR; PG8_SCHED;
            PG8_LDA(At, 1, 1); PG8_STAGE(PG8_SB(1, 0), b3, voffB); PG8_STAGE(PG8_SB(1, 1), b3 + hstep, voffB); PG8_STAGE(PG8_SA(1, 0), a3, voffA);
            PG8_WAIT_V(8); PG8_WAIT_L(0); PG8_BAR; PG8_MMA(1, 0, At, B0); PG8_MMA(1, 1, At, B1); PG8_BAR; PG8_SCHED;
            } else {
            PG8_LDB(B0, 0, 0); PG8_SCHED; PG8_LDA(At, 0, 0); PG8_STAGE(PG8_SA(1, 1), a1 + hstep, voffA);
            PG8_WAIT_L(8); PG8_BAR; PG8_WAIT_L(0); PG8_MMA(0, 0, At, B0); PG8_BAR; PG8_SCHED;
            PG8_LDB(B1, 0, 1); PG8_STAGE(PG8_SB(0, 0), b2, voffB);
            PG8_BAR; PG8_WAIT_L(0); PG8_MMA(0, 1, At, B1); PG8_BAR;
            PG8_LDA(At, 0, 1); PG8_STAGE(PG8_SA(0, 0), a2, voffA);
            PG8_BAR; PG8_WAIT_L(0); PG8_MMA(1, 0, At, B0); PG8_BAR; PG8_SCHED;
            PG8_STAGE(PG8_SB(0, 1), b2 + hstep, voffB);
            PG8_WAIT_V(6); PG8_BAR; PG8_MMA(1, 1, At, B1); PG8_BAR;
            PG8_LDB(B0, 1, 0); PG8_SCHED; PG8_LDA(At, 1, 0); PG8_STAGE(PG8_SA(0, 1), a2 + hstep, voffA);
            PG8_WAIT_L(8); PG8_BAR; PG8_WAIT_L(0); PG8_MMA(0, 0, At, B0); PG8_BAR; PG8_SCHED;
            PG8_LDB(B1, 1, 1); PG8_STAGE(PG8_SB(1, 0), b3, voffB);
            PG8_BAR; PG8_WAIT_L(0); PG8_MMA(0, 1, At, B1); PG8_BAR;
            PG8_LDA(At, 1, 1); PG8_STAGE(PG8_SA(1, 0), a3, voffA);
            PG8_BAR; PG8_WAIT_L(0); PG8_MMA(1, 0, At, B0); PG8_BAR; PG8_SCHED;
            PG8_STAGE(PG8_SB(1, 1), b3 + hstep, voffB);
            PG8_WAIT_V(6); PG8_BAR; PG8_MMA(1, 1, At, B1); PG8_BAR;
            }
        }
        if constexpr (ALIGN_EPI) { if (wr == 0) PG8_BAR; }
        if constexpr (!Epi::AFTER_DRAIN) { E(acc, cur, wr, wc, fr, fq); S.done(cur); }
        if (!has_next) break;
#pragma unroll
        for (int a = 0; a < 2; ++a)
#pragma unroll
            for (int b = 0; b < 2; ++b)
#pragma unroll
                for (int m = 0; m < 4; ++m)
#pragma unroll
                    for (int n = 0; n < 2; ++n) acc[a][b][m][n] = (f32x4){0.f, 0.f, 0.f, 0.f};
        cur = nxt; cA = nA; cB = nB; ++ui;
        if constexpr (ALIGN_EPI) { if (wr == 1) PG8_BAR; }
    }
    PG8_WAIT_V(0);
    if constexpr (!ALIGN_EPI) { if (wr == 0) PG8_BAR; }
    PG8_BAR;
    if constexpr (Epi::AFTER_DRAIN) { E.fused(acc, cur, wr, wc, fr, fq, lds, wid, lane); S.done(cur); }
#undef PG8_SA
#undef PG8_SB
#undef PG8_STAGE
#undef PG8_LDA
#undef PG8_LDB
#undef PG8_MMA
#undef PG8_WAIT_V
#undef PG8_WAIT_L
#undef PG8_BAR
#undef PG8_SCHED
}
}

constexpr int D = 1024, MROWS = 16384, NCTX = 8192, FF = 2816, FF2 = 5632;
constexpr float EPS = 1e-6f;
constexpr float LOG2E = 1.4426950408889634f;

constexpr size_t MiB = 1u << 20;
constexpr size_t WS_MOD = 1 * MiB;
constexpr size_t WS_BUPP = 2 * MiB;
constexpr size_t WS_WQKV0 = 3 * MiB, WS_WQKV3 = 6 * MiB, WS_WQKV2 = 9 * MiB;
constexpr size_t WS_WO0 = 13 * MiB, WS_WO2 = 15 * MiB, WS_WO3 = 17 * MiB, WS_WGLU = 19 * MiB;
constexpr size_t WS_WUP = 23 * MiB;
constexpr size_t WS_WDN = 67 * MiB;
constexpr size_t WS_C0K = 89 * MiB, WS_C0V = 91 * MiB, WS_C2K = 93 * MiB, WS_C2V = 97 * MiB, WS_C3K = 101 * MiB, WS_C3V = 103 * MiB;
constexpr size_t WS_ABUF = 106 * MiB;
constexpr size_t WS_XN = 106 * MiB;
constexpr size_t WS_R = 194 * MiB;
constexpr size_t WS_H = WS_R;
constexpr size_t WS_QKV = WS_R;
constexpr size_t WS_QN = WS_R + 64 * MiB;
constexpr size_t WS_KN = WS_R + 96 * MiB;
constexpr size_t WS_OB = WS_R + 112 * MiB;
constexpr size_t WS_YTMP = WS_R;
constexpr size_t WS_GACT = WS_R + 64 * MiB;
constexpr size_t WS_END = 370 * MiB;

#define LAS __attribute__((address_space(3)))
typedef unsigned short bf16;
typedef short bf16x8 __attribute__((ext_vector_type(8)));
typedef short s16x4 __attribute__((ext_vector_type(4)));
typedef float f32x4 __attribute__((ext_vector_type(4)));
typedef float f32x16 __attribute__((ext_vector_type(16)));
typedef unsigned u32x4 __attribute__((ext_vector_type(4)));
typedef unsigned u32x2 __attribute__((ext_vector_type(2)));

__device__ __forceinline__ float bf2f(bf16 v) { return __uint_as_float(((unsigned)v) << 16); }
__device__ __forceinline__ unsigned pk2(float lo, float hi) { return pg8::cvt_pk_bf16(lo, hi); }
__device__ __forceinline__ bf16 f2bf(float v) { return (bf16)(pk2(v, 0.f) & 0xffffu); }
__device__ __forceinline__ float shfl_xor_l(float v, int o, int lane) { return __int_as_float(__builtin_amdgcn_ds_bpermute((lane ^ o) << 2, __float_as_int(v))); }
__device__ __forceinline__ float wave_sum(float v, int lane) {
#pragma unroll
    for (int o = 1; o < 64; o <<= 1) v += shfl_xor_l(v, o, lane);
    return v;
}
__device__ __forceinline__ float fast_sin(float x) { const float r = x * 0.15915494309189535f; return __builtin_amdgcn_sinf(r - floorf(r)); }
__device__ __forceinline__ float fast_cos(float x) { const float r = x * 0.15915494309189535f; return __builtin_amdgcn_cosf(r - floorf(r)); }
__device__ __forceinline__ float silu_f(float v) { return v / (1.0f + __expf(-v)); }
__device__ __forceinline__ float gelu_tanh(float v) {
    const float z = 0.7978845608028654f * (v + 0.044715f * v * v * v);
    const float t = 1.0f - 2.0f / (__expf(2.0f * z) + 1.0f);
    return 0.5f * v * (1.0f + t);
}

struct Args { const float* in[45]; int ph_lo, ph_hi; };
__device__ __forceinline__ const float* inp(const Args& a, int i) { asm volatile("" : "+s"(i)); return a.in[i]; }

__device__ __forceinline__ int map_row(int n0, int mode) {
    if (mode == 1) { const int bj = n0 / FF, r = n0 % FF; return 256 * (r / 128) + 128 * bj + (r % 128); }
    if (mode == 2) { const int bj = n0 / 1024, r = n0 % 1024; return 256 * (r / 128) + 128 * bj + (r % 128); }
    return n0;
}
__device__ __forceinline__ void transpose_item(const float* W, int K, int N, bf16* WT, int mode, LAS float* scr, int item, int lane) {
    const int nblk = N / 32, kb = item / nblk, nb = item % nblk, k0 = 64 * kb, n0 = 32 * nb;
    const int r0 = map_row(n0, mode);
#pragma unroll 8
    for (int i = 0; i < 32; ++i) { const int kk = 2 * i + (lane >> 5); scr[kk * 33 + (lane & 31)] = W[(size_t)(k0 + kk) * N + n0 + (lane & 31)]; }
    asm volatile("s_waitcnt lgkmcnt(0)" ::: "memory"); __builtin_amdgcn_wave_barrier();
    const int c = lane & 7;
#pragma unroll
    for (int j = 0; j < 4; ++j) { const int n = (lane >> 3) + 8 * j; const LAS float* s = scr + (8 * c) * 33 + n;
        u32x4 o; o.x = pk2(s[0 * 33], s[1 * 33]); o.y = pk2(s[2 * 33], s[3 * 33]); o.z = pk2(s[4 * 33], s[5 * 33]); o.w = pk2(s[6 * 33], s[7 * 33]);
        *(u32x4*)(WT + (size_t)(r0 + n) * K + k0 + 8 * c) = o; }
    asm volatile("s_waitcnt lgkmcnt(0)" ::: "memory"); __builtin_amdgcn_wave_barrier();
}
__device__ __forceinline__ void prologue_phase(const Args& a, LAS unsigned char* lds, int tid, int wave, int lane) {
    unsigned char* ws = (unsigned char*)inp(a, 44);
    float* outp = (float*)inp(a, 43);
    const int G = gridDim.x, bx = blockIdx.x;
    {
        LAS float* sc = (LAS float*)lds;
        LAS float* red = (LAS float*)(lds + 36864);
        for (int i = tid; i < 9 * 1024; i += 512) { const int ci = i >> 10, k = i & 1023; const float v = ci < 8 ? inp(a, 9)[ci * 1024 + k] : inp(a, 10)[k]; sc[i] = silu_f(v); }
        __syncthreads();
        float* mod = (float*)(ws + WS_MOD);
        for (int u = bx; u < 4 * 96; u += G) {
            const int l = u / 96, c0 = (u % 96) * 64;
            const float* w = inp(a, 13) + (size_t)l * 1024 * 6144 + c0 + lane;
            float acc[9];
#pragma unroll
            for (int i = 0; i < 9; ++i) acc[i] = 0.f;
            const int kb = wave * 128;
#pragma unroll 4
            for (int k = 0; k < 128; ++k) { const float wv = w[(size_t)(kb + k) * 6144];
#pragma unroll
                for (int i = 0; i < 9; ++i) acc[i] += sc[i * 1024 + kb + k] * wv; }
#pragma unroll
            for (int i = 0; i < 9; ++i) red[(wave * 9 + i) * 64 + lane] = acc[i];
            __syncthreads();
            for (int o = tid; o < 9 * 64; o += 512) { const int i = o >> 6, cc = o & 63; float s = inp(a, 14)[l * 6144 + c0 + cc];
#pragma unroll
                for (int w8 = 0; w8 < 8; ++w8) s += red[(w8 * 9 + i) * 64 + cc];
                mod[((size_t)l * 9 + i) * 6144 + c0 + cc] = s; }
            __syncthreads();
        }
    }
    __syncthreads();
    {
        LAS float* scr = (LAS float*)(lds + wave * 16384);
        const int gw = bx * 8 + wave, NGW = G * 8;
        constexpr int I_QA = 16 * 48, I_QC = 16 * 64, I_O = 16 * 32, I_G = 16 * 64, I_UP = 16 * 176, I_DN = 44 * 32;
        constexpr int NITEMS = 2 * I_QA + I_QC + 3 * I_O + I_G + 4 * I_UP + 4 * I_DN;
        for (int it = gw; it < NITEMS; it += NGW) {
            int r = it;
            if (r < I_QA) { transpose_item(inp(a, 20), 1024, 1536, (bf16*)(ws + WS_WQKV0), 0, scr, r, lane); continue; } r -= I_QA;
            if (r < I_QA) { transpose_item(inp(a, 38), 1024, 1536, (bf16*)(ws + WS_WQKV3), 0, scr, r, lane); continue; } r -= I_QA;
            if (r < I_QC) { transpose_item(inp(a, 34), 1024, 2048, (bf16*)(ws + WS_WQKV2), 0, scr, r, lane); continue; } r -= I_QC;
            if (r < I_O) { transpose_item(inp(a, 24), 1024, 1024, (bf16*)(ws + WS_WO0), 0, scr, r, lane); continue; } r -= I_O;
            if (r < I_O) { transpose_item(inp(a, 37), 1024, 1024, (bf16*)(ws + WS_WO2), 0, scr, r, lane); continue; } r -= I_O;
            if (r < I_O) { transpose_item(inp(a, 42), 1024, 1024, (bf16*)(ws + WS_WO3), 0, scr, r, lane); continue; } r -= I_O;
            if (r < I_G) { transpose_item(inp(a, 33), 1024, 2048, (bf16*)(ws + WS_WGLU), 2, scr, r, lane); continue; } r -= I_G;
            if (r < 4 * I_UP) { const int l = r / I_UP; transpose_item(inp(a, 15) + (size_t)l * 1024 * FF2, 1024, FF2, (bf16*)(ws + WS_WUP) + (size_t)l * FF2 * 1024, 1, scr, r % I_UP, lane); continue; } r -= 4 * I_UP;
            { const int l = r / I_DN; transpose_item(inp(a, 19) + (size_t)l * FF * 1024, FF, 1024, (bf16*)(ws + WS_WDN) + (size_t)l * 1024 * FF, 0, scr, r % I_DN, lane); }
        }
    }
    const size_t gt = (size_t)bx * 512 + tid, NT = (size_t)G * 512;
    for (size_t i = gt; i < (size_t)MROWS * D / 4; i += NT) {
        const size_t half = (size_t)NCTX * D / 4;
        const f32x4 v = i < half ? ((const f32x4*)inp(a, 0))[i] : ((const f32x4*)inp(a, 1))[i - half];
        ((f32x4*)outp)[i] = v;
    }
    {
        const int srcs[6] = {2, 3, 5, 6, 7, 8};
        const size_t dsts[6] = {WS_C0K, WS_C0V, WS_C2K, WS_C2V, WS_C3K, WS_C3V};
        const size_t cnt[6] = {1048576, 1048576, 2097152, 2097152, 1048576, 1048576};
#pragma unroll
        for (int s = 0; s < 6; ++s) {
            const f32x4* src = (const f32x4*)inp(a, srcs[s]); u32x2* dst = (u32x2*)(ws + dsts[s]);
            for (size_t i = gt; i < cnt[s] / 4; i += NT) { const f32x4 v = src[i]; u32x2 o; o.x = pk2(v[0], v[1]); o.y = pk2(v[2], v[3]); dst[i] = o; }
        }
    }
    {
        float* bp = (float*)(ws + WS_BUPP);
        for (size_t i = gt; i < 4 * FF2; i += NT) { const int l = (int)(i / FF2), gc = (int)(i % FF2); const int pn = gc / 256, bj = (gc % 256) / 128, cc = gc % 128;
            bp[i] = inp(a, 16)[l * FF2 + bj * FF + pn * 128 + cc]; }
    }
}

__device__ __forceinline__ void norm_phase(const float* x, const float* gain, const float* mod, int shoff, int scoff, bf16* xn, int wave, int lane) {
    const int gw = blockIdx.x * 8 + wave, NGW = gridDim.x * 8;
    for (int row = gw; row < MROWS; row += NGW) {
        const int ci = row < NCTX ? 8 : ((row - NCTX) >> 10);
        const f32x4* xr = (const f32x4*)(x + (size_t)row * D) + lane;
        f32x4 v[4]; float s = 0.f;
#pragma unroll
        for (int j = 0; j < 4; ++j) { v[j] = xr[64 * j]; s += (v[j][0] * v[j][0] + v[j][1] * v[j][1]) + (v[j][2] * v[j][2] + v[j][3] * v[j][3]); }
        const float rstd = rsqrtf(wave_sum(s, lane) * (1.0f / D) + EPS);
        const float* mrow = mod + ci * 6144;
        u32x2* o8 = (u32x2*)(xn + (size_t)row * D) + lane;
#pragma unroll
        for (int j = 0; j < 4; ++j) {
            const int c = 4 * lane + 256 * j;
            const f32x4 g = *(const f32x4*)(gain + c), sh = *(const f32x4*)(mrow + shoff + c), sc = *(const f32x4*)(mrow + scoff + c);
            f32x4 y;
#pragma unroll
            for (int e = 0; e < 4; ++e) y[e] = (v[j][e] * rstd * g[e]) * (1.0f + sc[e]) + sh[e];
            u32x2 o; o.x = pk2(y[0], y[1]); o.y = pk2(y[2], y[3]); o8[64 * j] = o;
        }
    }
}

template <int DH>
__device__ __forceinline__ void qkprep_phase(const bf16* qkv, int NKV, const float* qg, const float* kg, bf16* qn, bf16* kn, float* outk, float* outv, int wave, int lane) {
    constexpr int LPH = DH / 2, HPI = 64 / LPH, QUARTER = DH / 4, NH = 1024 / DH;
    const int KW = NKV * DH, ldq = 1024 + 2 * KW;
    const int gw = blockIdx.x * 8 + wave, NGW = gridDim.x * 8;
    const float qscale = rsqrtf((float)DH) * LOG2E;
    const int pi = lane % LPH;
    const bool first = pi < QUARTER;
    const int fi = first ? pi : pi - QUARTER;
    const int d1 = first ? pi : DH / 2 + fi, d2 = d1 + QUARTER;
    const float freq = __builtin_amdgcn_exp2f(-(float)fi * (13.287712379549449f / (float)QUARTER));
    for (int row = gw; row < MROWS; row += NGW) {
        const bool lat = row >= NCTX;
        const int t = (row - NCTX) & 1023;
        const float pos = first ? (float)(t >> 6) : (float)(t & 63);
        float cs = 1.f, sn = 0.f;
        if (lat) { const float ang = pos * freq; cs = fast_cos(ang); sn = fast_sin(ang); }
        const bf16* src = qkv + (size_t)row * ldq;
        for (int hb = 0; hb < NH + NKV; hb += HPI) {
            const int head = hb + lane / LPH;
            const bool isk = head >= NH;
            const float x1 = bf2f(src[head * DH + d1]), x2 = bf2f(src[head * DH + d2]);
            float ss = x1 * x1 + x2 * x2;
#pragma unroll
            for (int o = 1; o < LPH; o <<= 1) ss += shfl_xor_l(ss, o, lane);
            const float rstd = rsqrtf(ss * (1.0f / DH) + EPS);
            const float* g = isk ? kg : qg;
            float y1 = x1 * rstd * g[d1], y2 = x2 * rstd * g[d2];
            if (!lat && isk) { float* ok = outk + (size_t)row * KW + (head - NH) * DH; ok[d1] = y1; ok[d2] = y2; }
            if (lat) { const float r1 = y1 * cs - y2 * sn, r2 = y1 * sn + y2 * cs; y1 = r1; y2 = r2; }
            if (!isk) { bf16* q = qn + (size_t)row * 1024 + head * DH; q[d1] = f2bf(y1 * qscale); q[d2] = f2bf(y2 * qscale); }
            else { bf16* k = kn + (size_t)row * KW + (head - NH) * DH; k[d1] = f2bf(y1); k[d2] = f2bf(y2); }
        }
        if (!lat) { const bf16* v = src + 1024 + KW; float* ov = outv + (size_t)row * KW;
            for (int j = lane; j < KW; j += 64) ov[j] = bf2f(v[j]); }
    }
}

template <int DH, bool WIN>
__device__ __forceinline__ void attn_phase(const bf16* qn, const bf16* kn, const bf16* qkv, const bf16* cK, const bf16* cV, const float* sink, bf16* ob,
                                           LAS unsigned char* lds, int tid, int wave, int lane) {
    constexpr int NH = 1024 / DH, NKV = 4, GQ = NH / NKV, KW = NKV * DH, ldq = 1024 + 2 * KW;
    constexpr int KSTR = DH * 2 + 16;
    constexpr int CPR = DH / 8;
    constexpr int NLD = 64 * CPR / 512;
    LAS unsigned char* Ks = lds;
    LAS unsigned char* Vs = lds + 64 * KSTR;
    const int r32 = lane & 31, hi = lane >> 5;
    const int n_lat = 8 * NH * 4, n_ctx = 32 * NH;
    for (int u = blockIdx.x; u < n_lat + n_ctx; u += gridDim.x) {
        const bool lat = u < n_lat;
        int b, h, q0, qrow0, ncache, kstart, ntl;
        if (lat) { b = u / (NH * 4); const int rem = u % (NH * 4); h = rem >> 2; q0 = (rem & 3) * 256; qrow0 = NCTX + b * 1024 + q0; ncache = 8;
            if (WIN) { kstart = q0 >= 128 ? q0 - 128 : 0; const int kend = q0 + 384 < 1024 ? q0 + 384 : 1024; ntl = (kend - kstart) >> 6; } else { kstart = 0; ntl = 16; } }
        else { const int uu = u - n_lat; b = uu / NH; h = uu % NH; q0 = 0; qrow0 = b * 256; ncache = 0; kstart = 0; ntl = 4; }
        const int kvh = h / GQ;
        const int krow0 = lat ? NCTX + b * 1024 : b * 256;
        const int nt = ncache + ntl;
        bf16x8 qf[DH / 16];
        { const bf16* qp = qn + (size_t)(qrow0 + wave * 32 + r32) * 1024 + h * DH + 8 * hi;
#pragma unroll
          for (int d0 = 0; d0 < DH / 16; ++d0) qf[d0] = *(const bf16x8*)(qp + 16 * d0); }
        float m, l;
        if (sink) { m = sink[h] * LOG2E; l = hi == 0 ? 1.f : 0.f; } else { m = -1e30f; l = 0.f; }
        f32x16 o[DH / 32];
#pragma unroll
        for (int db = 0; db < DH / 32; ++db)
#pragma unroll
            for (int r = 0; r < 16; ++r) o[db][r] = 0.f;
        const int qpos = q0 + wave * 32 + r32;
        u32x4 kreg[NLD], vreg[NLD];
        auto issue = [&](int t) {
            const bf16 *kp, *vp; size_t kpitch, vpitch;
            if (t < ncache) { kp = cK + ((size_t)(b * 512 + 64 * t) * NKV + kvh) * DH; vp = cV + ((size_t)(b * 512 + 64 * t) * NKV + kvh) * DH; kpitch = KW; vpitch = KW; }
            else { const int ks = kstart + 64 * (t - ncache); kp = kn + (size_t)(krow0 + ks) * KW + kvh * DH; vp = qkv + (size_t)(krow0 + ks) * ldq + 1024 + KW + kvh * DH; kpitch = KW; vpitch = ldq; }
#pragma unroll
            for (int i = 0; i < NLD; ++i) { const int c = tid + 512 * i, row = c / CPR, cc = c % CPR;
                kreg[i] = *(const u32x4*)(kp + (size_t)row * kpitch + cc * 8); vreg[i] = *(const u32x4*)(vp + (size_t)row * vpitch + cc * 8); }
        };
        issue(0);
        for (int t = 0; t < nt; ++t) {
            __syncthreads();
#pragma unroll
            for (int i = 0; i < NLD; ++i) { const int c = tid + 512 * i, row = c / CPR, cc = c % CPR;
                *(LAS u32x4*)(Ks + row * KSTR + cc * 16) = kreg[i]; *(LAS u32x4*)(Vs + row * KSTR + cc * 16) = vreg[i]; }
            __syncthreads();
            if (t + 1 < nt) issue(t + 1);
            const int kt0 = t < ncache ? -100000 : kstart + 64 * (t - ncache);
            bool active = true;
            if (WIN && lat && t >= ncache) { const int qw = q0 + wave * 32; if (kt0 + 63 < qw - 128 || kt0 > qw + 31 + 128) active = false; }
            if (active) {
                f32x16 p[2];
#pragma unroll
                for (int kh = 0; kh < 2; ++kh) {
#pragma unroll
                    for (int r = 0; r < 16; ++r) p[kh][r] = 0.f;
                    const LAS unsigned char* kb = Ks + (32 * kh + r32) * KSTR + 16 * hi;
#pragma unroll
                    for (int d0 = 0; d0 < DH / 16; ++d0) { const bf16x8 kf = *(const LAS bf16x8*)(kb + 32 * d0); p[kh] = __builtin_amdgcn_mfma_f32_32x32x16_bf16(kf, qf[d0], p[kh], 0, 0, 0); }
                }
                if (WIN && lat && t >= ncache) {
#pragma unroll
                    for (int kh = 0; kh < 2; ++kh)
#pragma unroll
                        for (int r = 0; r < 16; ++r) { const int kpos = kt0 + 32 * kh + (r & 3) + 8 * (r >> 2) + 4 * hi; const int dd = qpos - kpos; if (dd > 128 || dd < -128) p[kh][r] = -1e30f; }
                }
                float mx = p[0][0];
#pragma unroll
                for (int r = 1; r < 16; ++r) mx = fmaxf(mx, p[0][r]);
#pragma unroll
                for (int r = 0; r < 16; ++r) mx = fmaxf(mx, p[1][r]);
                mx = fmaxf(mx, shfl_xor_l(mx, 32, lane));
                const float mn = fmaxf(m, mx), sc = __builtin_amdgcn_exp2f(m - mn); m = mn;
                float ls = 0.f;
#pragma unroll
                for (int kh = 0; kh < 2; ++kh)
#pragma unroll
                    for (int r = 0; r < 16; ++r) { const float e = __builtin_amdgcn_exp2f(p[kh][r] - mn); p[kh][r] = e; ls += e; }
                l = l * sc + ls;
#pragma unroll
                for (int db = 0; db < DH / 32; ++db)
#pragma unroll
                    for (int r = 0; r < 16; ++r) o[db][r] *= sc;
                const int i16 = lane & 15, qq = i16 >> 2, pp = i16 & 3, blk = (lane >> 4) & 1;
#pragma unroll
                for (int kh = 0; kh < 2; ++kh)
#pragma unroll
                    for (int s2 = 0; s2 < 2; ++s2) {
                        u32x4 pw; pw.x = pk2(p[kh][8 * s2 + 0], p[kh][8 * s2 + 1]); pw.y = pk2(p[kh][8 * s2 + 2], p[kh][8 * s2 + 3]); pw.z = pk2(p[kh][8 * s2 + 4], p[kh][8 * s2 + 5]); pw.w = pk2(p[kh][8 * s2 + 6], p[kh][8 * s2 + 7]);
                        const bf16x8 pf = __builtin_bit_cast(bf16x8, pw);
                        const LAS unsigned char* vb = Vs + (32 * kh + 16 * s2 + 4 * hi + qq) * KSTR + 32 * blk + 8 * pp;
#pragma unroll
                        for (int db = 0; db < DH / 32; ++db) {
                            const s16x4 lo = __builtin_bit_cast(s16x4, __builtin_amdgcn_ds_read_tr16_b64_v4i16((LAS s16x4*)(vb + 64 * db)));
                            const s16x4 hh = __builtin_bit_cast(s16x4, __builtin_amdgcn_ds_read_tr16_b64_v4i16((LAS s16x4*)(vb + 64 * db + 8 * KSTR)));
                            const bf16x8 vf = __builtin_shufflevector(lo, hh, 0, 1, 2, 3, 4, 5, 6, 7);
                            o[db] = __builtin_amdgcn_mfma_f32_32x32x16_bf16(vf, pf, o[db], 0, 0, 0);
                        }
                    }
            }
        }
        l += shfl_xor_l(l, 32, lane);
        const float rl = 1.0f / l;
        bf16* op = ob + (size_t)(qrow0 + wave * 32 + r32) * 1024 + h * DH + 4 * hi;
#pragma unroll
        for (int db = 0; db < DH / 32; ++db)
#pragma unroll
            for (int g4 = 0; g4 < 4; ++g4) { u32x2 w; w.x = pk2(o[db][4 * g4] * rl, o[db][4 * g4 + 1] * rl); w.y = pk2(o[db][4 * g4 + 2] * rl, o[db][4 * g4 + 3] * rl);
                *(u32x2*)(op + 32 * db + 8 * g4) = w; }
        __syncthreads();
    }
}

template <int MODE>
__device__ __forceinline__ void s5_chunk(const bf16x8 af, const f32x4 yin, const bf16x8 (&bfr)[8], const bf16x8 (&cfr)[4], const bf16x8 dfr, const float ar, const float ai, float& hr, float& hi_,
                                         const int dir, float* yo, bf16* go, LAS float* Bu, LAS bf16* Hs, const int lane, const int n16, const int kq) {
    constexpr int BU_STR = 132, H_STR = 136;
#pragma unroll
    for (int nt = 0; nt < 8; ++nt) {
        f32x4 acc = {0.f, 0.f, 0.f, 0.f};
        acc = __builtin_amdgcn_mfma_f32_16x16x32_bf16(af, bfr[nt], acc, 0, 0, 0);
#pragma unroll
        for (int i = 0; i < 4; ++i) Bu[(4 * kq + i) * BU_STR + 16 * nt + n16] = acc[i];
    }
    asm volatile("s_waitcnt lgkmcnt(0)" ::: "memory"); __builtin_amdgcn_wave_barrier();
    LAS float* bp = Bu + (dir ? 15 * BU_STR : 0) + lane; const int bstep = dir ? -BU_STR : BU_STR;
    LAS bf16* hp = Hs + (dir ? 15 * H_STR : 0) + lane; const int hstep = dir ? -H_STR : H_STR;
#pragma unroll
    for (int st = 0; st < 16; ++st) {
        const float br = bp[st * bstep], bi = bp[st * bstep + 64];
        const float nr = ar * hr - ai * hi_ + br, ni = ar * hi_ + ai * hr + bi;
        hr = nr; hi_ = ni;
        if (MODE != 0) { hp[st * hstep] = f2bf(hr); hp[st * hstep + 64] = f2bf(hi_); }
    }
    if (MODE != 0) {
        asm volatile("s_waitcnt lgkmcnt(0)" ::: "memory"); __builtin_amdgcn_wave_barrier();
        f32x4 y = {0.f, 0.f, 0.f, 0.f};
        if (MODE == 2) y = yin;
#pragma unroll
        for (int ks = 0; ks < 4; ++ks) { const bf16x8 hf = *(const LAS bf16x8*)(Hs + n16 * H_STR + 32 * ks + 8 * kq); y = __builtin_amdgcn_mfma_f32_16x16x32_bf16(hf, cfr[ks], y, 0, 0, 0); }
        if (MODE == 1) {
#pragma unroll
            for (int i = 0; i < 4; ++i) yo[(size_t)i * D] = y[i];
        } else {
            y = __builtin_amdgcn_mfma_f32_16x16x32_bf16(af, dfr, y, 0, 0, 0);
#pragma unroll
            for (int i = 0; i < 4; ++i) go[(size_t)i * D] = f2bf(gelu_tanh(y[i]));
        }
    }
    asm volatile("s_waitcnt lgkmcnt(0)" ::: "memory"); __builtin_amdgcn_wave_barrier();
}
__device__ __forceinline__ void s5_phase(const Args& a, LAS unsigned char* lds, int wave, int lane) {
    constexpr int BU_STR = 132, WBYTES = 13056;
    LAS float* Bu = (LAS float*)(lds + wave * WBYTES);
    LAS bf16* Hs = (LAS bf16*)(lds + wave * WBYTES + 16 * BU_STR * 4);
    unsigned char* ws = (unsigned char*)inp(a, 44);
    const bf16* xn = (const bf16*)(ws + WS_XN);
    float* ytmp = (float*)(ws + WS_YTMP);
    bf16* gact = (bf16*)(ws + WS_GACT);
    const float *lam_re = inp(a, 25), *lam_im = inp(a, 26), *log_dt = inp(a, 27), *b_re = inp(a, 28), *b_im = inp(a, 29), *c_re = inp(a, 30), *c_im = inp(a, 31), *dskip = inp(a, 32);
    float* st_out = (float*)inp(a, 43) + 2 * (size_t)NCTX * D + 2 * 2097152;
    const int G = gridDim.x, gw = wave * G + blockIdx.x, NW = 8 * G;
    const int n16 = lane & 15, kq = lane >> 4;
    for (int u = gw; u < 4096; u += NW) {
        const bool lat = u < 2048;
        const int g = u & 63;
        const int seq = lat ? (u >> 8) : ((u - 2048) >> 6), sg = lat ? ((u >> 6) & 3) : 0;
        const int row0 = lat ? NCTX + seq * 1024 : seq * 256;
        const int ne = lat ? 5 : 2, total = ne * 16;
        const bf16* xl = xn + (size_t)(row0 + n16) * D + 16 * g + 8 * kq;
        const size_t ol = (size_t)(row0 + 4 * kq) * D + 16 * g + n16;
        bf16x8 dfr;
        { const float dv = dskip[16 * g + n16]; u32x4 w = {0u, 0u, 0u, 0u};
          if (kq < 2) { float v[8];
#pragma unroll
              for (int i = 0; i < 8; ++i) v[i] = (8 * kq + i == n16) ? dv : 0.f;
              w.x = pk2(v[0], v[1]); w.y = pk2(v[2], v[3]); w.z = pk2(v[4], v[5]); w.w = pk2(v[6], v[7]); }
          dfr = __builtin_bit_cast(bf16x8, w); }
        auto e_dir = [&](int e) -> int { return lat ? (e > sg ? 1 : 0) : e; };
        auto e_mode = [&](int e) -> int { return lat ? (e == sg ? 1 : (e == 4 ? 2 : 0)) : e + 1; };
        auto e_seg = [&](int e) -> int { return lat ? (e < sg ? e : ((e == sg || e == 4) ? sg : 4 + sg - e)) : 0; };
        auto chunk_row = [&](int c) -> int { const int e = c >> 4, ch = c & 15; return e_seg(e) * 256 + (e_dir(e) ? 15 - ch : ch) * 16; };
        u32x4 cur[4], nxt[4]; f32x4 ycur[4], ynxt[4];
#pragma unroll
        for (int k = 0; k < 4; ++k) { nxt[k] = (u32x4){0u, 0u, 0u, 0u}; ynxt[k] = (f32x4){0.f, 0.f, 0.f, 0.f}; if (kq < 2) nxt[k] = *(const u32x4*)(xl + (size_t)chunk_row(k) * D); }
        bf16x8 bfr[8], cfr[4]; float ar = 0.f, ai = 0.f, hr = 0.f, hi_ = 0.f;
        int cur_dir = -1;
#pragma unroll 1
        for (int e = 0; e < ne; ++e) {
            const int dir = e_dir(e), mode = e_mode(e), seg = e_seg(e);
            if (dir != cur_dir) {
                cur_dir = dir;
                const int gb = dir * 64 + g;
                const float dt = __expf(log_dt[gb]);
                { const float lr = lam_re[gb * 64 + lane], li = lam_im[gb * 64 + lane]; const float mag = __expf(lr * dt); ar = mag * fast_cos(li * dt); ai = mag * fast_sin(li * dt); }
#pragma unroll
                for (int nt = 0; nt < 8; ++nt) {
                    const int j = 16 * nt + n16, pp = j & 63; const bool im = j >= 64;
                    const float lr = lam_re[gb * 64 + pp], li = lam_im[gb * 64 + pp]; const float mag = __expf(lr * dt);
                    const float are = mag * fast_cos(li * dt), aim = mag * fast_sin(li * dt), den = lr * lr + li * li, nre = are - 1.0f;
                    const float fre = (nre * lr + aim * li) / den, fim = (aim * lr - nre * li) / den;
                    u32x4 w = {0u, 0u, 0u, 0u};
                    if (kq < 2) {
                        const float* br = b_re + ((size_t)gb * 64 + pp) * 16 + 8 * kq; const float* bi = b_im + ((size_t)gb * 64 + pp) * 16 + 8 * kq;
                        float v[8];
#pragma unroll
                        for (int i = 0; i < 8; ++i) v[i] = im ? (fre * bi[i] + fim * br[i]) : (fre * br[i] - fim * bi[i]);
                        w.x = pk2(v[0], v[1]); w.y = pk2(v[2], v[3]); w.z = pk2(v[4], v[5]); w.w = pk2(v[6], v[7]);
                    }
                    bfr[nt] = __builtin_bit_cast(bf16x8, w);
                }
#pragma unroll
                for (int ks = 0; ks < 4; ++ks) {
                    const int k0 = 32 * ks + 8 * kq;
                    float v[8];
#pragma unroll
                    for (int i = 0; i < 8; ++i) { const int k = k0 + i; v[i] = k < 64 ? c_re[((size_t)gb * 16 + n16) * 64 + k] : -c_im[((size_t)gb * 16 + n16) * 64 + (k - 64)]; }
                    u32x4 w; w.x = pk2(v[0], v[1]); w.y = pk2(v[2], v[3]); w.z = pk2(v[4], v[5]); w.w = pk2(v[6], v[7]);
                    cfr[ks] = __builtin_bit_cast(bf16x8, w);
                }
                hr = 0.f; hi_ = 0.f;
                if (lat) { const float* s0 = inp(a, 4) + ((size_t)(seq * 2 + dir) * 2) * 4096 + g * 64 + lane; hr = s0[0]; hi_ = s0[4096]; }
            }
#pragma unroll 1
            for (int c4 = 0; c4 < 16; c4 += 4) {
                const int gidx = e * 4 + (c4 >> 2);
                asm volatile("s_waitcnt vmcnt(0)" : "+v"(nxt[0]), "+v"(nxt[1]), "+v"(nxt[2]), "+v"(nxt[3]), "+v"(ynxt[0]), "+v"(ynxt[1]), "+v"(ynxt[2]), "+v"(ynxt[3]) :: "memory");
#pragma unroll
                for (int k = 0; k < 4; ++k) { cur[k] = nxt[k]; ycur[k] = ynxt[k]; }
                if (mode == 2 && c4 == 0) {
#pragma unroll
                    for (int k = 0; k < 4; ++k) { const float* yp = ytmp + ol + (size_t)(seg * 256 + (15 - k) * 16) * D;
#pragma unroll
                        for (int i = 0; i < 4; ++i) ycur[k][i] = yp[(size_t)i * D]; }
                    asm volatile("s_waitcnt vmcnt(0)" : "+v"(ycur[0]), "+v"(ycur[1]), "+v"(ycur[2]), "+v"(ycur[3]) :: "memory");
                }
                if (gidx + 1 < ne * 4) {
                    const int e2 = (gidx + 1) >> 2, c42 = ((gidx + 1) & 3) * 4;
#pragma unroll
                    for (int k = 0; k < 4; ++k) if (kq < 2) nxt[k] = *(const u32x4*)(xl + (size_t)chunk_row((gidx + 1) * 4 + k) * D);
                    if (e_mode(e2) == 2 && c42 != 0) {
#pragma unroll
                        for (int k = 0; k < 4; ++k) { const float* yp = ytmp + ol + (size_t)(e_seg(e2) * 256 + (15 - (c42 + k)) * 16) * D;
#pragma unroll
                            for (int i = 0; i < 4; ++i) ynxt[k][i] = yp[(size_t)i * D]; }
                    }
                }
#pragma unroll
                for (int k = 0; k < 4; ++k) {
                    const int ch = c4 + k;
                    const bf16x8 af = __builtin_bit_cast(bf16x8, cur[k]);
                    const f32x4 yin = ycur[k];
                    const size_t orow = ol + (size_t)(seg * 256 + (dir ? 15 - ch : ch) * 16) * D;
                    if (mode == 0) s5_chunk<0>(af, yin, bfr, cfr, dfr, ar, ai, hr, hi_, dir, ytmp + orow, gact + orow, Bu, Hs, lane, n16, kq);
                    else if (mode == 1) s5_chunk<1>(af, yin, bfr, cfr, dfr, ar, ai, hr, hi_, dir, ytmp + orow, gact + orow, Bu, Hs, lane, n16, kq);
                    else s5_chunk<2>(af, yin, bfr, cfr, dfr, ar, ai, hr, hi_, dir, ytmp + orow, gact + orow, Bu, Hs, lane, n16, kq);
                }
            }
            if (!lat) { float* so = st_out + ((size_t)(seq * 2 + dir) * 2) * 4096 + g * 64 + lane; so[0] = hr; so[4096] = hi_; }
        }
    }
}

__device__ __forceinline__ void conv_phase(const bf16* h, const float* ck, const float* cb, bf16* abuf, int tid) {
    const size_t NT = (size_t)gridDim.x * 512;
    for (size_t task = (size_t)blockIdx.x * 512 + tid; task < (size_t)352 * 1024; task += NT) {
        const int cgp = (int)(task % 352), rc = (int)(task / 352);
        const int j0 = cgp * 8, pn = j0 >> 7, jj = j0 & 127, hcol = 256 * pn + jj;
        const int r0 = rc * 16, L = r0 < NCTX ? 256 : 1024;
        const bool pv = (r0 % L) != 0, nv = ((r0 + 16) % L) != 0;
        float k0g[8], k1g[8], k2g[8], bg[8], k0v[8], k1v[8], k2v[8], bv[8];
#pragma unroll
        for (int e = 0; e < 8; ++e) { k0g[e] = ck[j0 + e]; k1g[e] = ck[FF2 + j0 + e]; k2g[e] = ck[2 * FF2 + j0 + e]; bg[e] = cb[j0 + e];
            k0v[e] = ck[FF + j0 + e]; k1v[e] = ck[FF2 + FF + j0 + e]; k2v[e] = ck[2 * FF2 + FF + j0 + e]; bv[e] = cb[FF + j0 + e]; }
        const bf16* hp = h + (size_t)r0 * FF2 + hcol;
        const u32x4 z = {0u, 0u, 0u, 0u};
        u32x4 gp = pv ? *(const u32x4*)(hp - FF2) : z, vp = pv ? *(const u32x4*)(hp - FF2 + 128) : z;
        u32x4 gc = *(const u32x4*)(hp), vc = *(const u32x4*)(hp + 128);
#pragma unroll 4
        for (int i = 0; i < 16; ++i) {
            const bool has = (i < 15) || nv;
            const u32x4 gn = has ? *(const u32x4*)(hp + (size_t)(i + 1) * FF2) : z, vn = has ? *(const u32x4*)(hp + (size_t)(i + 1) * FF2 + 128) : z;
            float o[8];
#pragma unroll
            for (int e = 0; e < 8; ++e) {
                const float a0 = __uint_as_float((e & 1) ? (gp[e >> 1] & 0xffff0000u) : (gp[e >> 1] << 16));
                const float a1 = __uint_as_float((e & 1) ? (gc[e >> 1] & 0xffff0000u) : (gc[e >> 1] << 16));
                const float a2 = __uint_as_float((e & 1) ? (gn[e >> 1] & 0xffff0000u) : (gn[e >> 1] << 16));
                const float b0 = __uint_as_float((e & 1) ? (vp[e >> 1] & 0xffff0000u) : (vp[e >> 1] << 16));
                const float b1 = __uint_as_float((e & 1) ? (vc[e >> 1] & 0xffff0000u) : (vc[e >> 1] << 16));
                const float b2 = __uint_as_float((e & 1) ? (vn[e >> 1] & 0xffff0000u) : (vn[e >> 1] << 16));
                const float gt = bg[e] + k0g[e] * a0 + k1g[e] * a1 + k2g[e] * a2;
                const float vl = bv[e] + k0v[e] * b0 + k1v[e] * b1 + k2v[e] * b2;
                o[e] = silu_f(gt) * vl;
            }
            u32x4 w; w.x = pk2(o[0], o[1]); w.y = pk2(o[2], o[3]); w.z = pk2(o[4], o[5]); w.w = pk2(o[6], o[7]);
            *(u32x4*)(abuf + (size_t)(r0 + i) * FF + j0) = w;
            gp = gc; vp = vc; gc = gn; vc = vn;
        }
    }
}

#define XB_TMO      128
#define XB_XCNT(j)  (256  + 64 * (j))
#define XB_XSUB(j)  (1280 + 64 * (j))
#define XB_XGEN(j)  (2304 + 64 * (j))
#define XB_TOP      3328
#define XB_TOPGEN   3392
#define XCD_BAR_WORDS 3456
#define XB_SPIN_CAP (1u << 18)

__device__ __forceinline__ unsigned xb_ld(unsigned* p)              { return __hip_atomic_load(p, __ATOMIC_RELAXED, __HIP_MEMORY_SCOPE_AGENT); }
__device__ __forceinline__ unsigned xb_add(unsigned* p, unsigned v) { return __hip_atomic_fetch_add(p, v, __ATOMIC_RELAXED, __HIP_MEMORY_SCOPE_AGENT); }
__device__ __forceinline__ unsigned xb_xcc_id() { return (unsigned)__builtin_amdgcn_s_getreg((3 << 11) | 20) & 0xFu; }
#define XB_SPIN(cond, bar) do { unsigned _sp = 0; while (cond) { __builtin_amdgcn_s_sleep(1); \
    if ((++_sp & 255u) == 0u) { if (xb_ld(&(bar)[XB_TMO])) break; if (_sp > XB_SPIN_CAP) { atomicAdd(&(bar)[XB_TMO], 1u); break; } } } } while (0)

struct XcdBarrier {
    unsigned* bar; unsigned x;
    volatile LAS unsigned* st;
};

__device__ __forceinline__ XcdBarrier xcd_barrier_post(unsigned* bar, volatile LAS unsigned* st) {
    XcdBarrier b; b.bar = bar; b.x = xb_xcc_id(); b.st = st;
    if (threadIdx.x == 0) (void)xb_add(&bar[XB_XCNT(b.x)], 1u);
    return b;
}
__device__ __forceinline__ void xcd_barrier_complete(unsigned* bar, unsigned x, unsigned& nloc, unsigned& nx) {
    const unsigned G = gridDim.x * gridDim.y * gridDim.z;
    unsigned sum, cnt, mine, sp = 0u;
    for (;;) {
        sum = 0u; cnt = 0u; mine = 0u;
#pragma unroll
        for (unsigned j = 0; j < 16; ++j) { const unsigned c = xb_ld(&bar[XB_XCNT(j)]); sum += c; cnt += (c > 0u) ? 1u : 0u; mine = (j == x) ? c : mine; }
        if (sum == G) break;
        __builtin_amdgcn_s_sleep(1);
        if ((++sp & 255u) == 0u) { if (xb_ld(&bar[XB_TMO])) break; if (sp > XB_SPIN_CAP) { atomicAdd(&bar[XB_TMO], 1u); break; } }
    }
    nloc = mine > 0u ? mine : 1u; nx = cnt > 0u ? cnt : 1u;
}

__device__ __forceinline__ void xcd_barrier(const XcdBarrier& b) {
    asm volatile("s_waitcnt vmcnt(0)" ::: "memory");
    __syncthreads();
    if (threadIdx.x == 0) {
        unsigned* bar = b.bar;
        __builtin_amdgcn_s_waitcnt(0);
        unsigned nloc = b.st[0], nx = b.st[1];
        if (nloc == 0u) { xcd_barrier_complete(bar, b.x, nloc, nx); b.st[0] = nloc; b.st[1] = nx; }
        const unsigned old = xb_add(&bar[XB_XSUB(b.x)], 1u);
        const unsigned gen = old / nloc;
        if (old + 1u == (gen + 1u) * nloc) {
            __builtin_amdgcn_fence(__ATOMIC_RELEASE, "agent");
            asm volatile("s_waitcnt vmcnt(0)" ::: "memory");
            const unsigned og = xb_add(&bar[XB_TOP], 1u);
            const unsigned tg = og / nx;
            if (og + 1u == (tg + 1u) * nx) xb_add(&bar[XB_TOPGEN], 1u);
            else XB_SPIN(xb_ld(&bar[XB_TOPGEN]) == tg, bar);
            __builtin_amdgcn_fence(__ATOMIC_ACQUIRE, "agent");
            xb_add(&bar[XB_XGEN(b.x)], 1u);
            asm volatile("s_waitcnt vmcnt(0)" ::: "memory");
        } else {
            XB_SPIN(xb_ld(&bar[XB_XGEN(b.x)]) == gen, bar);
            __builtin_amdgcn_fence(__ATOMIC_ACQUIRE, "agent");
            asm volatile("s_waitcnt vmcnt(0)" ::: "memory");
        }
    }
    __syncthreads();
}

constexpr int LDS_BYTES = 147456;
constexpr int NPHASE = 37;
__global__ void __launch_bounds__(512, 2) hybrid_fwd(Args a) {
    extern __shared__ __attribute__((aligned(16))) unsigned char lds_raw[];
    LAS unsigned char* lds = (LAS unsigned char*)lds_raw;
    cg::grid_group grid = cg::this_grid();
    if (a.ph_lo < 0) grid.sync();
    { volatile LAS unsigned* m = (volatile LAS unsigned*)(lds + 131072); if (threadIdx.x < 16) m[threadIdx.x] = 0u; }
    __syncthreads();
    XcdBarrier bar = xcd_barrier_post((unsigned*)inp(a, 44), (volatile LAS unsigned*)(lds + 131072) + 8);
    bool first = true;
    for (int idx = a.ph_lo; idx < a.ph_hi; ++idx) {
        int ph = idx;
        if (PROBE_DUP >= 0 && idx > PROBE_DUP) ph = idx - 1;
        int tid = threadIdx.x; asm volatile("" : "+v"(tid));
        const int lane = tid & 63, wave = __builtin_amdgcn_readfirstlane(tid >> 6);
        unsigned char* ws = (unsigned char*)inp(a, 44);
        float* x = (float*)inp(a, 43);
        bf16* xn = (bf16*)(ws + WS_XN);
        const int l = (ph - 1) / 9, sub = (ph - 1) % 9;
        if (ph > 0 && l == 1 && (sub == 3 || sub == 4)) continue;
        if (!first) xcd_barrier(bar);
        first = false;
        #ifndef NO_PRO
        if (ph == 0) { prologue_phase(a, lds, tid, wave, lane); continue; }
#endif
        const float* mod = (const float*)(ws + WS_MOD) + (size_t)l * 9 * 6144;
        const int kind = (l == 1) ? 1 : (l == 2 ? 2 : 0);
        const int nqkv = kind == 2 ? 2048 : 1536;
        bf16* qkv = (bf16*)(ws + WS_QKV); bf16* qn = (bf16*)(ws + WS_QN); bf16* kn = (bf16*)(ws + WS_KN); bf16* ob = (bf16*)(ws + WS_OB);
#ifndef NO_NORM
        if (sub == 0) { norm_phase(x, inp(a, 11) + l * D, mod, 0, 1024, xn, wave, lane); continue; }
        if (sub == 5) { norm_phase(x, inp(a, 12) + l * D, mod, 3072, 4096, xn, wave, lane); continue; }
#endif
#ifndef NO_GEMM
        {
            const bool isg = (sub == 1 && kind != 1) || sub == 6 || (sub == 4 && kind != 1) || sub == 8 || (sub == 2 && kind == 1);
            if (isg) {
                pg8::Gemm g; pg8::EpiMulti E;
                E.e0 = pg8::EpiBf16<0>{qkv, nqkv, nullptr, 0, 0, 1.f}; E.e1 = pg8::EpiResGate{x, mod, 2048}; E.e2 = pg8::EpiGlu{x, mod, 2048};
                if (sub == 1) { const bf16* wt = (const bf16*)(ws + (l == 0 ? WS_WQKV0 : (l == 2 ? WS_WQKV2 : WS_WQKV3))); g = pg8::Gemm{xn, wt, MROWS, nqkv, D}; E.mode = 0; }
                else if (sub == 6) { g = pg8::Gemm{xn, (const bf16*)(ws + WS_WUP) + (size_t)l * FF2 * 1024, MROWS, FF2, D}; E.mode = 0;
                    E.e0 = pg8::EpiBf16<0>{(bf16*)(ws + WS_H), FF2, (const float*)(ws + WS_BUPP) + l * FF2, 0, 0, 1.f}; }
                else if (sub == 4) { const bf16* wt = (const bf16*)(ws + (l == 0 ? WS_WO0 : (l == 2 ? WS_WO2 : WS_WO3))); g = pg8::Gemm{ob, wt, MROWS, D, D}; E.mode = 1; }
                else if (sub == 8) { g = pg8::Gemm{(const bf16*)(ws + WS_ABUF), (const bf16*)(ws + WS_WDN) + (size_t)l * 1024 * FF, MROWS, D, FF}; E.mode = 1; E.e1.goff = 5120; }
                else { g = pg8::Gemm{(const bf16*)(ws + WS_GACT), (const bf16*)(ws + WS_WGLU), MROWS, 2048, D}; E.mode = 2; }
                pg8::StaticOrder S; S.init(g.M, g.N, gridDim.x, (int)blockIdx.x);
                pg8::gemm_phase<pg8::EpiMulti, pg8::StaticOrder, true, true>(lds, g, S, E, tid);
                continue;
            }
        }
#endif
#ifndef NO_CONV
        if (sub == 7) { conv_phase((const bf16*)(ws + WS_H), inp(a, 17) + (size_t)l * 3 * FF2, inp(a, 18) + (size_t)l * FF2, (bf16*)(ws + WS_ABUF), tid); continue; }
#endif
        if (kind == 1) {
#ifndef NO_S5
            if (sub == 1) { s5_phase(a, lds, wave, lane); continue; }
#endif
            continue;
        }
        float* o_k = x + 2 * (size_t)NCTX * D + (l == 0 ? 0 : (l == 2 ? 2 * 2097152 + 524288 : 2 * 2097152 + 524288 + 2 * 4194304));
#ifndef NO_QKP
        if (sub == 2) {
            if (kind == 0) qkprep_phase<64>(qkv, 4, inp(a, l == 0 ? 21 : 39), inp(a, l == 0 ? 22 : 40), qn, kn, o_k, o_k + 2097152, wave, lane);
            else qkprep_phase<128>(qkv, 4, inp(a, 35), inp(a, 36), qn, kn, o_k, o_k + 4194304, wave, lane);
            continue;
        }
#endif
#ifndef NO_ATT
        if (sub == 3) {
            if (kind == 0) attn_phase<64, true>(qn, kn, qkv, (const bf16*)(ws + (l == 0 ? WS_C0K : WS_C3K)), (const bf16*)(ws + (l == 0 ? WS_C0V : WS_C3V)), inp(a, l == 0 ? 23 : 41), ob, lds, tid, wave, lane);
            else attn_phase<128, false>(qn, kn, qkv, (const bf16*)(ws + WS_C2K), (const bf16*)(ws + WS_C2V), nullptr, ob, lds, tid, wave, lane);
            continue;
        }
#endif
    }
}

extern "C" void kernel_launch(void* const* d_in, const int* in_sizes, int n_in, void* d_out, int out_size, void* d_ws, size_t ws_size, hipStream_t stream) {
    static int grid = 0;
    if (grid == 0) {
        if (n_in != 43 || ws_size < WS_END) { fprintf(stderr, "kernel_launch: unexpected n_in %d / ws_size %zu (need %zu)\n", n_in, ws_size, (size_t)WS_END); grid = -1; return; }
        int dev = 0, cus = 0, per_cu = 0;
        hipGetDevice(&dev);
        hipDeviceGetAttribute(&cus, hipDeviceAttributeMultiprocessorCount, dev);
        hipFuncSetAttribute((const void*)hybrid_fwd, hipFuncAttributeMaxDynamicSharedMemorySize, LDS_BYTES);
        hipOccupancyMaxActiveBlocksPerMultiprocessor(&per_cu, (const void*)hybrid_fwd, 512, LDS_BYTES);
        if (per_cu < 1) per_cu = 1;
        (void)hipGetLastError();
        grid = cus * per_cu;
        if (grid > 256) grid = 256;
    }
    if (grid < 0) return;
    if (hipMemsetAsync(d_ws, 0, 65536, stream) != hipSuccess) { fprintf(stderr, "kernel_launch: memset failed\n"); return; }
    Args a{};
    for (int i = 0; i < 43; ++i) a.in[i] = (const float*)d_in[i];
    a.in[43] = (const float*)d_out; a.in[44] = (const float*)d_ws;
#if ONE_LAUNCH
    a.ph_lo = 0; a.ph_hi = NPHASE + (PROBE_DUP >= 0 ? 1 : 0);
    void* kargs[] = {&a};
    hipError_t e = hipLaunchCooperativeKernel((const void*)hybrid_fwd, dim3(grid), dim3(512), kargs, LDS_BYTES, stream);
    if (e != hipSuccess) fprintf(stderr, "cooperative launch failed: %s (grid %d)\n", hipGetErrorString(e), grid);
#else
    for (int ph = 0; ph < NPHASE; ++ph) {
        const int l = (ph - 1) / 9, sub = (ph - 1) % 9;
        if (ph > 0 && l == 1 && (sub == 3 || sub == 4)) continue;
        a.ph_lo = ph; a.ph_hi = ph + 1;
        hipLaunchKernelGGL(hybrid_fwd, dim3(grid), dim3(512), LDS_BYTES, stream, a);
    }
#endif
}
```

```cpp
#include <hip/hip_runtime.h>
#include <hip/hip_cooperative_groups.h>
#include <cstdio>
#include <cstdint>
namespace cg = cooperative_groups;
#ifndef ONE_LAUNCH
#define ONE_LAUNCH 1
#endif
#ifndef PROBE_DUP
#define PROBE_DUP -1
#endif
#ifndef USE_OLD_S5
#define USE_OLD_S5 0
#endif
#ifndef S5_PARANOID
#define S5_PARANOID 0
#endif
#ifndef S5_MIX
#define S5_MIX 1
#endif
namespace pg8 {
#define PG8_LAS __attribute__((address_space(3)))
typedef unsigned short bf16_t;
typedef short bf16x8 __attribute__((ext_vector_type(8)));
typedef float f32x4 __attribute__((ext_vector_type(4)));
typedef unsigned u32x4 __attribute__((ext_vector_type(4)));
constexpr int BM = 256, BK = 64, HALF = 128, HTB = HALF * BK * 2  , STAGE_BYTES = 8 * HTB, NXCD = 8, WGM = 8;

__host__ __device__ __forceinline__ int lds_byte(int r, int c) { const int st = (r >> 4) * 2 + (c >> 5), rr = r & 15, cc = c & 31, ob = rr * 64 + cc * 2; return st * 1024 + (ob ^ (((ob >> 9) & 1) << 5)); }
__host__ __device__ __forceinline__ void stage_rc(int b, int& R, int& C) { const int st = b / 1024, sb = b % 1024, swz = sb ^ (((sb >> 9) & 1) << 5); R = (st >> 1) * 16 + swz / 64; C = (st & 1) * 32 + (swz % 64) / 2; }
__host__ __device__ __forceinline__ int perm32(int rho) { const int n = rho >> 4, i = rho & 15; return 8 * (i >> 2) + 4 * n + (i & 3); }

struct Unit { int pm, pn; };
struct Gemm { const bf16_t* A; const bf16_t* Bt; int M, N, K; };

struct StaticOrder {
    int nM, nN, nwg, G, c;
    __host__ __device__ void init(int M, int N, int G_, int c_) { nM = M / BM; nN = N / BM; nwg = nM * nN; G = G_; c = c_; }
    __host__ __device__ bool next(int i, Unit& u) const {
        const long L = (long)i * G + c; if (L >= nwg) return false;
        int wgid = (int)L; { const int q = nwg / NXCD, r = nwg % NXCD, xcd = wgid % NXCD, off = wgid / NXCD; wgid = (xcd < r ? xcd * (q + 1) : r * (q + 1) + (xcd - r) * q) + off; }
        const int nig = WGM * nN, gid = wgid / nig, fm = gid * WGM, gsz = (nM - fm) < WGM ? (nM - fm) : WGM;
        u.pm = fm + ((wgid % nig) % gsz); u.pn = (wgid % nig) / gsz; return true;
    }
    __device__ __forceinline__ void a_ready(const Unit&) const {}
    __device__ __forceinline__ void done(const Unit&) const {}
};

typedef float f32x2c __attribute__((ext_vector_type(2))); typedef __bf16 bf16x2c __attribute__((ext_vector_type(2)));
__device__ __forceinline__ unsigned cvt_pk_bf16(float lo, float hi) { f32x2c v = {lo, hi}; bf16x2c b = __builtin_convertvector(v, bf16x2c); return __builtin_bit_cast(unsigned, b); }
typedef float f32x2 __attribute__((ext_vector_type(2)));
__device__ __forceinline__ f32x2 gelu_pk(f32x2 v) {
    const f32x2 av = __builtin_elementwise_abs(v), d = av * 0.2316418882f + 1.0f;
    f32x2 t; t.x = __builtin_amdgcn_rcpf(d.x); t.y = __builtin_amdgcn_rcpf(d.y);
    f32x2 q = t * 0.5307027145f + (-0.7265760135f); q = q * t + 0.7107068705f; q = q * t + (-0.142248368f); q = q * t + 0.127414796f; q = q * t;
    const f32x2 s = (v * v) * (-0.72134752044f);
    f32x2 e; e.x = __builtin_amdgcn_exp2f(s.x); e.y = __builtin_amdgcn_exp2f(s.y);
    const f32x2 m = v * (q * e), r = v - m;
    f32x2 o; o.x = v.x < 0.f ? m.x : r.x; o.y = v.y < 0.f ? m.y : r.y; return o;
}

template <int ACT  > struct EpiBf16 {
    static constexpr bool PERM = true, AFTER_DRAIN = false; static_assert(ACT == 0 || ACT == 1, "EpiBf16: ACT is 0 (none) or 1 (gelu_pk)");
    bf16_t* O; int ldc; const float* bias; int split_cols; size_t split_stride; float scale0;
    __device__ __forceinline__ void operator()(const f32x4 (&acc)[2][2][4][2], const Unit& u, int wr, int wc, int fr, int fq) const {
        const int row0 = u.pm * BM + wr * 64 + fr; int colt = u.pn * BM; bf16_t* base = O;
        float sc = 1.f; if (split_cols) { const int t = colt / split_cols; base += (size_t)t * split_stride; colt -= t * split_cols; if (t == 0) sc = scale0; }
        const int col0 = colt + wc * 32 + 8 * fq, bcol0 = u.pn * BM + wc * 32 + 8 * fq;
        f32x4 bv[2][2];
#pragma unroll
        for (int bj = 0; bj < 2; ++bj)
#pragma unroll
            for (int n = 0; n < 2; ++n) bv[bj][n] = bias ? *(const f32x4*)(bias + bcol0 + bj * HALF + 4 * n) : (f32x4){0.f, 0.f, 0.f, 0.f};
#pragma unroll
        for (int ai = 0; ai < 2; ++ai)
#pragma unroll
            for (int m = 0; m < 4; ++m) { bf16_t* rowp = base + (size_t)(row0 + ai * HALF + m * 16) * ldc + col0;
#pragma unroll
                for (int bj = 0; bj < 2; ++bj) { f32x4 v0 = acc[ai][bj][m][0] + bv[bj][0], v1 = acc[ai][bj][m][1] + bv[bj][1];
                    if (ACT == 1) { f32x2 a = gelu_pk((f32x2){v0[0], v0[1]}), b = gelu_pk((f32x2){v0[2], v0[3]}), c = gelu_pk((f32x2){v1[0], v1[1]}), d = gelu_pk((f32x2){v1[2], v1[3]});
                        v0 = (f32x4){a.x, a.y, b.x, b.y}; v1 = (f32x4){c.x, c.y, d.x, d.y}; }
                    v0 = v0 * sc; v1 = v1 * sc; u32x4 w; w.x = cvt_pk_bf16(v0[0], v0[1]); w.y = cvt_pk_bf16(v0[2], v0[3]); w.z = cvt_pk_bf16(v1[0], v1[1]); w.w = cvt_pk_bf16(v1[2], v1[3]);
                    *(u32x4*)(rowp + bj * HALF) = w; } }
    }
};
struct EpiResGate {
    static constexpr bool PERM = false, AFTER_DRAIN = false;
    float* x; const float* mod; int goff;
    __device__ __forceinline__ void operator()(const f32x4 (&acc)[2][2][4][2], const Unit& u, int wr, int wc, int fr, int fq) const {
        const int ci = u.pm < 32 ? 8 : ((u.pm - 32) >> 2);
        const float* g = mod + ci * 6144 + goff;
        const int col0 = u.pn * BM + wc * 32 + 4 * fq;
        f32x4 gv[2][2];
#pragma unroll
        for (int bj = 0; bj < 2; ++bj)
#pragma unroll
            for (int n = 0; n < 2; ++n) gv[bj][n] = *(const f32x4*)(g + col0 + bj * HALF + n * 16);
#pragma unroll
        for (int ai = 0; ai < 2; ++ai)
#pragma unroll
            for (int m = 0; m < 4; ++m) { float* xr = x + (size_t)(u.pm * BM + ai * HALF + wr * 64 + m * 16 + fr) * 1024 + col0;
#pragma unroll
                for (int bj = 0; bj < 2; ++bj)
#pragma unroll
                    for (int n = 0; n < 2; ++n) { f32x4 v = *(const f32x4*)(xr + bj * HALF + n * 16); v = v + gv[bj][n] * acc[ai][bj][m][n]; *(f32x4*)(xr + bj * HALF + n * 16) = v; }
                asm volatile("" ::: "memory"); }
    }
};
struct EpiGlu {
    static constexpr bool PERM = false, AFTER_DRAIN = false;
    float* x; const float* mod; int goff;
    __device__ __forceinline__ void operator()(const f32x4 (&acc)[2][2][4][2], const Unit& u, int wr, int wc, int fr, int fq) const {
        const int ci = u.pm < 32 ? 8 : ((u.pm - 32) >> 2);
        const float* g = mod + ci * 6144 + goff;
        const int col0 = u.pn * HALF + wc * 32 + 4 * fq;
        f32x4 gv[2];
#pragma unroll
        for (int n = 0; n < 2; ++n) gv[n] = *(const f32x4*)(g + col0 + n * 16);
#pragma unroll
        for (int ai = 0; ai < 2; ++ai)
#pragma unroll
            for (int m = 0; m < 4; ++m) { float* xr = x + (size_t)(u.pm * BM + ai * HALF + wr * 64 + m * 16 + fr) * 1024 + col0;
#pragma unroll
                for (int n = 0; n < 2; ++n) { const f32x4 h = acc[ai][0][m][n], hg = acc[ai][1][m][n]; f32x4 s;
#pragma unroll
                    for (int e = 0; e < 4; ++e) s[e] = h[e] / (1.0f + __expf(-hg[e]));
                    f32x4 v = *(const f32x4*)(xr + n * 16); v = v + gv[n] * s; *(f32x4*)(xr + n * 16) = v; }
                asm volatile("" ::: "memory"); }
    }
};

struct EpiMulti {
    static constexpr bool AFTER_DRAIN = false;
    int mode; EpiBf16<0> e0; EpiResGate e1; EpiGlu e2;
    __device__ __forceinline__ bool perm() const { return mode == 0; }
    __device__ __forceinline__ void operator()(const f32x4 (&acc)[2][2][4][2], const Unit& u, int wr, int wc, int fr, int fq) const {
        if (mode == 0) e0(acc, u, wr, wc, fr, fq); else if (mode == 1) e1(acc, u, wr, wc, fr, fq); else e2(acc, u, wr, wc, fr, fq);
    }
};
template <class Epi, class Sched, bool ALIGN_EPI = false, bool SP2 = false>
__device__ __forceinline__ void gemm_phase(PG8_LAS unsigned char* lds, const Gemm g, const Sched& S, const Epi& E, const int tid) {
    const int wid = __builtin_amdgcn_readfirstlane(tid >> 6), lane = tid & 63, wr = wid >> 2, wc = wid & 3, fr = lane & 15, fq = lane >> 4;
    const int K = g.K, nt = K / BK;
    unsigned voffA[2], voffB[2];
#pragma unroll
    for (int i = 0; i < 2; ++i) { int R, C; stage_rc(tid * 16 + i * 8192, R, C); const int Rb = E.perm() ? ((R & ~31) + perm32(R & 31)) : R;
        voffA[i] = (unsigned)(R * K + C) * 2u; voffB[i] = (unsigned)(Rb * K + C) * 2u; }
    const size_t kstep = (size_t)(BK * 2);
    const size_t hstep = (size_t)HALF * K * 2;
    const size_t tstep = 2 * hstep;
    const unsigned ldsw = (unsigned)wid * 1024u;
    const int aoff = lds_byte(wr * 64 + fr, fq * 8), boff = lds_byte(wc * 32 + fr, fq * 8);
#define PG8_SA(b, h) (((b) * 2 + (h)) * HTB)
#define PG8_SB(b, h) ((4 + (b) * 2 + (h)) * HTB)
#define PG8_STAGE(bufoff, gbase, voff) do { _Pragma("unroll") for (int _i = 0; _i < 2; ++_i) \
        __builtin_amdgcn_global_load_lds((const unsigned*)((const char*)(gbase) + (voff)[_i]), (PG8_LAS unsigned*)(lds + (bufoff) + ldsw + _i * 8192), 16, 0, 0); } while (0)
#define PG8_LDA(dst, b, h) do { _Pragma("unroll") for (int m = 0; m < 4; ++m) _Pragma("unroll") for (int k = 0; k < 2; ++k) dst[m][k] = *(const PG8_LAS bf16x8*)(lds + PG8_SA(b, h) + aoff + m * 2048 + k * 1024); } while (0)
#define PG8_LDB(dst, b, h) do { _Pragma("unroll") for (int n = 0; n < 2; ++n) _Pragma("unroll") for (int k = 0; k < 2; ++k) dst[n][k] = *(const PG8_LAS bf16x8*)(lds + PG8_SB(b, h) + boff + n * 2048 + k * 1024); } while (0)
#define PG8_MMA(ai, bj, At, Bt) do { __builtin_amdgcn_s_setprio(1); _Pragma("unroll") for (int m = 0; m < 4; ++m) _Pragma("unroll") for (int n = 0; n < 2; ++n) _Pragma("unroll") for (int k = 0; k < 2; ++k) \
        acc[ai][bj][m][n] = __builtin_amdgcn_mfma_f32_16x16x32_bf16(Bt[n][k], At[m][k], acc[ai][bj][m][n], 0, 0, 0); __builtin_amdgcn_s_setprio(0); } while (0)
#define PG8_WAIT_V(n) asm volatile("s_waitcnt vmcnt(" #n ")" ::: "memory")
#define PG8_WAIT_L(n) asm volatile("s_waitcnt lgkmcnt(" #n ")" ::: "memory")
#define PG8_BAR __builtin_amdgcn_s_barrier()
#define PG8_SCHED __builtin_amdgcn_sched_barrier(0)
    Unit cur, nxt; int ui = 0;
    if (!S.next(0, cur)) return;
    f32x4 acc[2][2][4][2];
#pragma unroll
    for (int a = 0; a < 2; ++a)
#pragma unroll
        for (int b = 0; b < 2; ++b)
#pragma unroll
            for (int m = 0; m < 4; ++m)
#pragma unroll
                for (int n = 0; n < 2; ++n) acc[a][b][m][n] = (f32x4){0.f, 0.f, 0.f, 0.f};
    bf16x8 At[4][2], B0[2][2], B1[2][2];
    const char* cA = (const char*)g.A + (size_t)cur.pm * tstep; const char* cB = (const char*)g.Bt + (size_t)cur.pn * tstep;
    S.a_ready(cur);
    if constexpr (SP2) {
        PG8_STAGE(PG8_SB(0, 0), cB, voffB); PG8_STAGE(PG8_SB(0, 1), cB + hstep, voffB); PG8_STAGE(PG8_SA(0, 0), cA, voffA); PG8_STAGE(PG8_SA(0, 1), cA + hstep, voffA);
        if (wr == 1) PG8_BAR;
        PG8_WAIT_V(2); PG8_BAR;
        PG8_STAGE(PG8_SB(1, 0), cB + kstep, voffB); PG8_STAGE(PG8_SA(1, 0), cA + kstep, voffA); PG8_STAGE(PG8_SB(1, 1), cB + hstep + kstep, voffB);
        PG8_WAIT_V(6); PG8_BAR;
    } else {
        PG8_STAGE(PG8_SB(0, 0), cB, voffB); PG8_STAGE(PG8_SA(0, 0), cA, voffA); PG8_STAGE(PG8_SB(0, 1), cB + hstep, voffB); PG8_STAGE(PG8_SA(0, 1), cA + hstep, voffA);
        if (wr == 1) PG8_BAR;
        PG8_WAIT_V(4); PG8_BAR;
        PG8_STAGE(PG8_SB(1, 0), cB + kstep, voffB); PG8_STAGE(PG8_SA(1, 0), cA + kstep, voffA); PG8_STAGE(PG8_SB(1, 1), cB + hstep + kstep, voffB);
        PG8_WAIT_V(6); PG8_BAR;
    }
    for (;;) {
        const bool has_next = S.next(ui + 1, nxt);
        const char* nA = has_next ? (const char*)g.A + (size_t)nxt.pm * tstep : cA; const char* nB = has_next ? (const char*)g.Bt + (size_t)nxt.pn * tstep : cB;
        for (int t = 0; t < nt; t += 2) {
            const bool last = (t == nt - 2);
            const char* a1 = cA + (size_t)(t + 1) * kstep;
            const char* a2 = last ? nA : cA + (size_t)(t + 2) * kstep; const char* b2 = last ? nB : cB + (size_t)(t + 2) * kstep;
            const char* a3 = a2 + kstep; const char* b3 = b2 + kstep;
            if (last && has_next) S.a_ready(nxt);
            if constexpr (SP2) {
            PG8_LDB(B0, 0, 0); PG8_LDB(B1, 0, 1); PG8_SCHED; PG8_LDA(At, 0, 0); PG8_STAGE(PG8_SA(1, 1), a1 + hstep, voffA);
            PG8_WAIT_V(8); PG8_WAIT_L(0); PG8_BAR; PG8_MMA(0, 0, At, B0); PG8_MMA(0, 1, At, B1); PG8_BAR; PG8_SCHED;
            PG8_LDA(At, 0, 1); PG8_STAGE(PG8_SB(0, 0), b2, voffB); PG8_STAGE(PG8_SB(0, 1), b2 + hstep, voffB); PG8_STAGE(PG8_SA(0, 0), a2, voffA);
            PG8_WAIT_V(8); PG8_WAIT_L(0); PG8_BAR; PG8_MMA(1, 0, At, B0); PG8_MMA(1, 1, At, B1); PG8_BAR; PG8_SCHED;
            PG8_LDB(B0, 1, 0); PG8_LDB(B1, 1, 1); PG8_SCHED; PG8_LDA(At, 1, 0); PG8_STAGE(PG8_SA(0, 1), a2 + hstep, voffA);
            PG8_WAIT_V(8); PG8_WAIT_L(0); PG8_BAR; PG8_MMA(0, 0, At, B0); PG8_MMA(0, 1, At, B1); PG8_BAR; PG8_SCHED;
            PG8_LDA(At, 1, 1); PG8_STAGE(PG8_SB(1, 0), b3, voffB); PG8_STAGE(PG8_SB(1, 1), b3 + hstep, voffB); PG8_STAGE(PG8_SA(1, 0), a3, voffA);
            PG8_WAIT_V(8); PG8_WAIT_L(0); PG8_BAR; PG8_MMA(1, 0, At, B0); PG8_MMA(1, 1, At, B1); PG8_BAR; PG8_SCHED;
            } else {
            PG8_LDB(B0, 0, 0); PG8_SCHED; PG8_LDA(At, 0, 0); PG8_STAGE(PG8_SA(1, 1), a1 + hstep, voffA);
            PG8_WAIT_L(8); PG8_BAR; PG8_WAIT_L(0); PG8_MMA(0, 0, At, B0); PG8_BAR; PG8_SCHED;
            PG8_LDB(B1, 0, 1); PG8_STAGE(PG8_SB(0, 0), b2, voffB);
            PG8_BAR; PG8_WAIT_L(0); PG8_MMA(0, 1, At, B1); PG8_BAR;
            PG8_LDA(At, 0, 1); PG8_STAGE(PG8_SA(0, 0), a2, voffA);
            PG8_BAR; PG8_WAIT_L(0); PG8_MMA(1, 0, At, B0); PG8_BAR; PG8_SCHED;
            PG8_STAGE(PG8_SB(0, 1), b2 + hstep, voffB);
            PG8_WAIT_V(6); PG8_BAR; PG8_MMA(1, 1, At, B1); PG8_BAR;
            PG8_LDB(B0, 1, 0); PG8_SCHED; PG8_LDA(At, 1, 0); PG8_STAGE(PG8_SA(0, 1), a2 + hstep, voffA);
            PG8_WAIT_L(8); PG8_BAR; PG8_WAIT_L(0); PG8_MMA(0, 0, At, B0); PG8_BAR; PG8_SCHED;
            PG8_LDB(B1, 1, 1); PG8_STAGE(PG8_SB(1, 0), b3, voffB);
            PG8_BAR; PG8_WAIT_L(0); PG8_MMA(0, 1, At, B1); PG8_BAR;
            PG8_LDA(At, 1, 1); PG8_STAGE(PG8_SA(1, 0), a3, voffA);
            PG8_BAR; PG8_WAIT_L(0); PG8_MMA(1, 0, At, B0); PG8_BAR; PG8_SCHED;
            PG8_STAGE(PG8_SB(1, 1), b3 + hstep, voffB);
            PG8_WAIT_V(6); PG8_BAR; PG8_MMA(1, 1, At, B1); PG8_BAR;
            }
        }
        if constexpr (ALIGN_EPI) { if (wr == 0) PG8_BAR; }
        if constexpr (!Epi::AFTER_DRAIN) { E(acc, cur, wr, wc, fr, fq); S.done(cur); }
        if (!has_next) break;
#pragma unroll
        for (int a = 0; a < 2; ++a)
#pragma unroll
            for (int b = 0; b < 2; ++b)
#pragma unroll
                for (int m = 0; m < 4; ++m)
#pragma unroll
                    for (int n = 0; n < 2; ++n) acc[a][b][m][n] = (f32x4){0.f, 0.f, 0.f, 0.f};
        cur = nxt; cA = nA; cB = nB; ++ui;
        if constexpr (ALIGN_EPI) { if (wr == 1) PG8_BAR; }
    }
    PG8_WAIT_V(0);
    if constexpr (!ALIGN_EPI) { if (wr == 0) PG8_BAR; }
    PG8_BAR;
    if constexpr (Epi::AFTER_DRAIN) { E.fused(acc, cur, wr, wc, fr, fq, lds, wid, lane); S.done(cur); }
#undef PG8_SA
#undef PG8_SB
#undef PG8_STAGE
#undef PG8_LDA
#undef PG8_LDB
#undef PG8_MMA
#undef PG8_WAIT_V
#undef PG8_WAIT_L
#undef PG8_BAR
#undef PG8_SCHED
}
}

constexpr int D = 1024, MROWS = 16384, NCTX = 8192, FF = 2816, FF2 = 5632;
constexpr float EPS = 1e-6f;
constexpr float LOG2E = 1.4426950408889634f;

constexpr size_t MiB = 1u << 20;
constexpr size_t WS_MOD = 1 * MiB;
constexpr size_t WS_BUPP = 2 * MiB;
constexpr size_t WS_WQKV0 = 3 * MiB, WS_WQKV3 = 6 * MiB, WS_WQKV2 = 9 * MiB;
constexpr size_t WS_WO0 = 13 * MiB, WS_WO2 = 15 * MiB, WS_WO3 = 17 * MiB, WS_WGLU = 19 * MiB;
constexpr size_t WS_WUP = 23 * MiB;
constexpr size_t WS_WDN = 67 * MiB;
constexpr size_t WS_C0K = 89 * MiB, WS_C0V = 91 * MiB, WS_C2K = 93 * MiB, WS_C2V = 97 * MiB, WS_C3K = 101 * MiB, WS_C3V = 103 * MiB;
constexpr size_t WS_ABUF = 106 * MiB;
constexpr size_t WS_XN = 106 * MiB;
constexpr size_t WS_R = 194 * MiB;
constexpr size_t WS_H = WS_R;
constexpr size_t WS_QKV = WS_R;
constexpr size_t WS_QN = WS_R + 64 * MiB;
constexpr size_t WS_KN = WS_R + 96 * MiB;
constexpr size_t WS_OB = WS_R + 112 * MiB;
constexpr size_t WS_YTMP = WS_R;
constexpr size_t WS_GACT = WS_R + 64 * MiB;
constexpr size_t WS_END = 370 * MiB;

#define LAS __attribute__((address_space(3)))
typedef unsigned short bf16;
typedef short bf16x8 __attribute__((ext_vector_type(8)));
typedef short s16x4 __attribute__((ext_vector_type(4)));
typedef float f32x4 __attribute__((ext_vector_type(4)));
typedef float f32x16 __attribute__((ext_vector_type(16)));
typedef unsigned u32x4 __attribute__((ext_vector_type(4)));
typedef unsigned u32x2 __attribute__((ext_vector_type(2)));

__device__ __forceinline__ float bf2f(bf16 v) { return __uint_as_float(((unsigned)v) << 16); }
__device__ __forceinline__ unsigned pk2(float lo, float hi) { return pg8::cvt_pk_bf16(lo, hi); }
__device__ __forceinline__ bf16 f2bf(float v) { return (bf16)(pk2(v, 0.f) & 0xffffu); }
__device__ __forceinline__ float shfl_xor_l(float v, int o, int lane) { return __int_as_float(__builtin_amdgcn_ds_bpermute((lane ^ o) << 2, __float_as_int(v))); }
__device__ __forceinline__ float wave_sum(float v, int lane) {
#pragma unroll
    for (int o = 1; o < 64; o <<= 1) v += shfl_xor_l(v, o, lane);
    return v;
}
__device__ __forceinline__ float fast_sin(float x) { const float r = x * 0.15915494309189535f; return __builtin_amdgcn_sinf(r - floorf(r)); }
__device__ __forceinline__ float fast_cos(float x) { const float r = x * 0.15915494309189535f; return __builtin_amdgcn_cosf(r - floorf(r)); }
__device__ __forceinline__ float silu_f(float v) { return v / (1.0f + __expf(-v)); }
__device__ __forceinline__ float gelu_tanh(float v) {
    const float z = 0.7978845608028654f * (v + 0.044715f * v * v * v);
    const float t = 1.0f - 2.0f / (__expf(2.0f * z) + 1.0f);
    return 0.5f * v * (1.0f + t);
}

struct Args { const float* in[45]; int ph_lo, ph_hi; };
__device__ __forceinline__ const float* inp(const Args& a, int i) { asm volatile("" : "+s"(i)); return a.in[i]; }

__device__ __forceinline__ int map_row(int n0, int mode) {
    if (mode == 1) { const int bj = n0 / FF, r = n0 % FF; return 256 * (r / 128) + 128 * bj + (r % 128); }
    if (mode == 2) { const int bj = n0 / 1024, r = n0 % 1024; return 256 * (r / 128) + 128 * bj + (r % 128); }
    return n0;
}
__device__ __forceinline__ void transpose_item(const float* W, int K, int N, bf16* WT, int mode, LAS float* scr, int item, int lane) {
    const int nblk = N / 32, kb = item / nblk, nb = item % nblk, k0 = 64 * kb, n0 = 32 * nb;
    const int r0 = map_row(n0, mode);
#pragma unroll 8
    for (int i = 0; i < 32; ++i) { const int kk = 2 * i + (lane >> 5); scr[kk * 33 + (lane & 31)] = W[(size_t)(k0 + kk) * N + n0 + (lane & 31)]; }
    asm volatile("s_waitcnt lgkmcnt(0)" ::: "memory"); __builtin_amdgcn_wave_barrier();
    const int c = lane & 7;
#pragma unroll
    for (int j = 0; j < 4; ++j) { const int n = (lane >> 3) + 8 * j; const LAS float* s = scr + (8 * c) * 33 + n;
        u32x4 o; o.x = pk2(s[0 * 33], s[1 * 33]); o.y = pk2(s[2 * 33], s[3 * 33]); o.z = pk2(s[4 * 33], s[5 * 33]); o.w = pk2(s[6 * 33], s[7 * 33]);
        *(u32x4*)(WT + (size_t)(r0 + n) * K + k0 + 8 * c) = o; }
    asm volatile("s_waitcnt lgkmcnt(0)" ::: "memory"); __builtin_amdgcn_wave_barrier();
}
__device__ __forceinline__ void prologue_phase(const Args& a, LAS unsigned char* lds, int tid, int wave, int lane) {
    unsigned char* ws = (unsigned char*)inp(a, 44);
    float* outp = (float*)inp(a, 43);
    const int G = gridDim.x, bx = blockIdx.x;
    {
        LAS float* sc = (LAS float*)lds;
        LAS float* red = (LAS float*)(lds + 36864);
        for (int i = tid; i < 9 * 1024; i += 512) { const int ci = i >> 10, k = i & 1023; const float v = ci < 8 ? inp(a, 9)[ci * 1024 + k] : inp(a, 10)[k]; sc[i] = silu_f(v); }
        __syncthreads();
        float* mod = (float*)(ws + WS_MOD);
        for (int u = bx; u < 4 * 96; u += G) {
            const int l = u / 96, c0 = (u % 96) * 64;
            const float* w = inp(a, 13) + (size_t)l * 1024 * 6144 + c0 + lane;
            float acc[9];
#pragma unroll
            for (int i = 0; i < 9; ++i) acc[i] = 0.f;
            const int kb = wave * 128;
#pragma unroll 4
            for (int k = 0; k < 128; ++k) { const float wv = w[(size_t)(kb + k) * 6144];
#pragma unroll
                for (int i = 0; i < 9; ++i) acc[i] += sc[i * 1024 + kb + k] * wv; }
#pragma unroll
            for (int i = 0; i < 9; ++i) red[(wave * 9 + i) * 64 + lane] = acc[i];
            __syncthreads();
            for (int o = tid; o < 9 * 64; o += 512) { const int i = o >> 6, cc = o & 63; float s = inp(a, 14)[l * 6144 + c0 + cc];
#pragma unroll
                for (int w8 = 0; w8 < 8; ++w8) s += red[(w8 * 9 + i) * 64 + cc];
                mod[((size_t)l * 9 + i) * 6144 + c0 + cc] = s; }
            __syncthreads();
        }
    }
    __syncthreads();
    {
        LAS float* scr = (LAS float*)(lds + wave * 16384);
        const int gw = bx * 8 + wave, NGW = G * 8;
        constexpr int I_QA = 16 * 48, I_QC = 16 * 64, I_O = 16 * 32, I_G = 16 * 64, I_UP = 16 * 176, I_DN = 44 * 32;
        constexpr int NITEMS = 2 * I_QA + I_QC + 3 * I_O + I_G + 4 * I_UP + 4 * I_DN;
        for (int it = gw; it < NITEMS; it += NGW) {
            int r = it;
            if (r < I_QA) { transpose_item(inp(a, 20), 1024, 1536, (bf16*)(ws + WS_WQKV0), 0, scr, r, lane); continue; } r -= I_QA;
            if (r < I_QA) { transpose_item(inp(a, 38), 1024, 1536, (bf16*)(ws + WS_WQKV3), 0, scr, r, lane); continue; } r -= I_QA;
            if (r < I_QC) { transpose_item(inp(a, 34), 1024, 2048, (bf16*)(ws + WS_WQKV2), 0, scr, r, lane); continue; } r -= I_QC;
            if (r < I_O) { transpose_item(inp(a, 24), 1024, 1024, (bf16*)(ws + WS_WO0), 0, scr, r, lane); continue; } r -= I_O;
            if (r < I_O) { transpose_item(inp(a, 37), 1024, 1024, (bf16*)(ws + WS_WO2), 0, scr, r, lane); continue; } r -= I_O;
            if (r < I_O) { transpose_item(inp(a, 42), 1024, 1024, (bf16*)(ws + WS_WO3), 0, scr, r, lane); continue; } r -= I_O;
            if (r < I_G) { transpose_item(inp(a, 33), 1024, 2048, (bf16*)(ws + WS_WGLU), 2, scr, r, lane); continue; } r -= I_G;
            if (r < 4 * I_UP) { const int l = r / I_UP; transpose_item(inp(a, 15) + (size_t)l * 1024 * FF2, 1024, FF2, (bf16*)(ws + WS_WUP) + (size_t)l * FF2 * 1024, 1, scr, r % I_UP, lane); continue; } r -= 4 * I_UP;
            { const int l = r / I_DN; transpose_item(inp(a, 19) + (size_t)l * FF * 1024, FF, 1024, (bf16*)(ws + WS_WDN) + (size_t)l * 1024 * FF, 0, scr, r % I_DN, lane); }
        }
    }
    const size_t gt = (size_t)bx * 512 + tid, NT = (size_t)G * 512;
    for (size_t i = gt; i < (size_t)MROWS * D / 4; i += NT) {
        const size_t half = (size_t)NCTX * D / 4;
        const f32x4 v = i < half ? ((const f32x4*)inp(a, 0))[i] : ((const f32x4*)inp(a, 1))[i - half];
        ((f32x4*)outp)[i] = v;
    }
    {
        const int srcs[6] = {2, 3, 5, 6, 7, 8};
        const size_t dsts[6] = {WS_C0K, WS_C0V, WS_C2K, WS_C2V, WS_C3K, WS_C3V};
        const size_t cnt[6] = {1048576, 1048576, 2097152, 2097152, 1048576, 1048576};
#pragma unroll
        for (int s = 0; s < 6; ++s) {
            const f32x4* src = (const f32x4*)inp(a, srcs[s]); u32x2* dst = (u32x2*)(ws + dsts[s]);
            for (size_t i = gt; i < cnt[s] / 4; i += NT) { const f32x4 v = src[i]; u32x2 o; o.x = pk2(v[0], v[1]); o.y = pk2(v[2], v[3]); dst[i] = o; }
        }
    }
    {
        float* bp = (float*)(ws + WS_BUPP);
        for (size_t i = gt; i < 4 * FF2; i += NT) { const int l = (int)(i / FF2), gc = (int)(i % FF2); const int pn = gc / 256, bj = (gc % 256) / 128, cc = gc % 128;
            bp[i] = inp(a, 16)[l * FF2 + bj * FF + pn * 128 + cc]; }
    }
}

__device__ __forceinline__ void norm_phase(const float* x, const float* gain, const float* mod, int shoff, int scoff, bf16* xn, int wave, int lane) {
    const int gw = blockIdx.x * 8 + wave, NGW = gridDim.x * 8;
    for (int row = gw; row < MROWS; row += NGW) {
        const int ci = row < NCTX ? 8 : ((row - NCTX) >> 10);
        const f32x4* xr = (const f32x4*)(x + (size_t)row * D) + lane;
        f32x4 v[4]; float s = 0.f;
#pragma unroll
        for (int j = 0; j < 4; ++j) { v[j] = xr[64 * j]; s += (v[j][0] * v[j][0] + v[j][1] * v[j][1]) + (v[j][2] * v[j][2] + v[j][3] * v[j][3]); }
        const float rstd = rsqrtf(wave_sum(s, lane) * (1.0f / D) + EPS);
        const float* mrow = mod + ci * 6144;
        u32x2* o8 = (u32x2*)(xn + (size_t)row * D) + lane;
#pragma unroll
        for (int j = 0; j < 4; ++j) {
            const int c = 4 * lane + 256 * j;
            const f32x4 g = *(const f32x4*)(gain + c), sh = *(const f32x4*)(mrow + shoff + c), sc = *(const f32x4*)(mrow + scoff + c);
            f32x4 y;
#pragma unroll
            for (int e = 0; e < 4; ++e) y[e] = (v[j][e] * rstd * g[e]) * (1.0f + sc[e]) + sh[e];
            u32x2 o; o.x = pk2(y[0], y[1]); o.y = pk2(y[2], y[3]); o8[64 * j] = o;
        }
    }
}

template <int DH>
__device__ __forceinline__ void qkprep_phase(const bf16* qkv, int NKV_, const float* qg, const float* kg, bf16* qn, bf16* kn, float* outk, float* outv, int wave, int lane) {
    constexpr int NKV = 4, LPU = DH / 16, HL = LPU / 2, QUARTER = DH / 4, NH = 1024 / DH, KW = NKV * DH, ldq = 1024 + 2 * KW, TPR = (NH + NKV) * LPU;
    (void)NKV_;
    const int gw = blockIdx.x * 8 + wave, NGW = gridDim.x * 8;
    const float qscale = rsqrtf((float)DH) * LOG2E;
    constexpr int TOTAL = MROWS * TPR;
    for (int T0 = gw * 64; T0 < TOTAL; T0 += NGW * 64) {
        const int T = T0 + lane, row = T / TPR, j = T - row * TPR, head = j / LPU, li = j % LPU, half = li / HL, w = li % HL;
        const int d1b = half * (DH / 2) + 8 * w;
        const bool lat = row >= NCTX, isk = head >= NH;
        const int t = (row - NCTX) & 1023;
        const float pos = half == 0 ? (float)(t >> 6) : (float)(t & 63);
        const bf16* src = qkv + (size_t)row * ldq + head * DH + d1b;
        const u32x4 r1 = *(const u32x4*)src, r2 = *(const u32x4*)(src + QUARTER);
        float x1[8], x2[8]; float ss = 0.f;
#pragma unroll
        for (int e = 0; e < 4; ++e) { x1[2 * e] = __uint_as_float(r1[e] << 16); x1[2 * e + 1] = __uint_as_float(r1[e] & 0xffff0000u); x2[2 * e] = __uint_as_float(r2[e] << 16); x2[2 * e + 1] = __uint_as_float(r2[e] & 0xffff0000u); }
#pragma unroll
        for (int e = 0; e < 8; ++e) ss += x1[e] * x1[e] + x2[e] * x2[e];
#pragma unroll
        for (int o = 1; o < LPU; o <<= 1) ss += shfl_xor_l(ss, o, lane);
        const float rstd = rsqrtf(ss * (1.0f / DH) + EPS);
        const float* g = (isk ? kg : qg) + d1b;
        const f32x4 ga = *(const f32x4*)g, gb = *(const f32x4*)(g + 4), gc = *(const f32x4*)(g + QUARTER), gd = *(const f32x4*)(g + QUARTER + 4);
#pragma unroll
        for (int e = 0; e < 8; ++e) { x1[e] *= rstd * (e < 4 ? ga[e & 3] : gb[e & 3]); x2[e] *= rstd * (e < 4 ? gc[e & 3] : gd[e & 3]); }
        if (!lat && isk) { float* ok = outk + (size_t)row * KW + (head - NH) * DH + d1b;
            *(f32x4*)ok = (f32x4){x1[0], x1[1], x1[2], x1[3]}; *(f32x4*)(ok + 4) = (f32x4){x1[4], x1[5], x1[6], x1[7]};
            *(f32x4*)(ok + QUARTER) = (f32x4){x2[0], x2[1], x2[2], x2[3]}; *(f32x4*)(ok + QUARTER + 4) = (f32x4){x2[4], x2[5], x2[6], x2[7]}; }
        if (lat) {
#pragma unroll
            for (int e = 0; e < 8; ++e) { const float freq = __builtin_amdgcn_exp2f(-(float)(8 * w + e) * (13.287712379549449f / (float)QUARTER));
                const float ang = pos * freq, cs = fast_cos(ang), sn = fast_sin(ang); const float a1 = x1[e] * cs - x2[e] * sn, a2 = x1[e] * sn + x2[e] * cs; x1[e] = a1; x2[e] = a2; }
        }
        const float sc = isk ? 1.0f : qscale;
        u32x4 o1, o2;
#pragma unroll
        for (int e = 0; e < 4; ++e) { o1[e] = pk2(x1[2 * e] * sc, x1[2 * e + 1] * sc); o2[e] = pk2(x2[2 * e] * sc, x2[2 * e + 1] * sc); }
        bf16* dst = isk ? kn + (size_t)row * KW + (head - NH) * DH + d1b : qn + (size_t)row * 1024 + head * DH + d1b;
        *(u32x4*)dst = o1; *(u32x4*)(dst + QUARTER) = o2;
    }
    constexpr int VC = KW / 8;
    for (int task = gw * 64 + lane; task < NCTX * VC; task += NGW * 64) { const int row = task / VC, c = task % VC;
        const u32x4 r = *(const u32x4*)(qkv + (size_t)row * ldq + 1024 + KW + 8 * c); float* ov = outv + (size_t)row * KW + 8 * c;
        *(f32x4*)ov = (f32x4){__uint_as_float(r[0] << 16), __uint_as_float(r[0] & 0xffff0000u), __uint_as_float(r[1] << 16), __uint_as_float(r[1] & 0xffff0000u)};
        *(f32x4*)(ov + 4) = (f32x4){__uint_as_float(r[2] << 16), __uint_as_float(r[2] & 0xffff0000u), __uint_as_float(r[3] << 16), __uint_as_float(r[3] & 0xffff0000u)}; }
}

template <int DH, bool WIN>
__device__ __forceinline__ void attn_phase(const bf16* qn, const bf16* kn, const bf16* qkv, const bf16* cK, const bf16* cV, const float* sink, bf16* ob,
                                           LAS unsigned char* lds, int tid, int wave, int lane) {
    constexpr int NH = 1024 / DH, NKV = 4, GQ = NH / NKV, KW = NKV * DH, ldq = 1024 + 2 * KW;
    constexpr int KSTR = DH * 2 + 16;
    constexpr int CPR = DH / 8;
    constexpr int NLD = 64 * CPR / 512;
    LAS unsigned char* Ks = lds;
    LAS unsigned char* Vs = lds + 64 * KSTR;
    const int r32 = lane & 31, hi = lane >> 5;
    const int n_lat = 8 * NH * 4, n_ctx = 32 * NH;
    for (int u = blockIdx.x; u < n_lat + n_ctx; u += gridDim.x) {
        const bool lat = u < n_lat;
        int b, h, q0, qrow0, ncache, kstart, ntl;
        if (lat) { b = u / (NH * 4); const int rem = u % (NH * 4); h = rem >> 2; q0 = (rem & 3) * 256; qrow0 = NCTX + b * 1024 + q0; ncache = 8;
            if (WIN) { kstart = q0 >= 128 ? q0 - 128 : 0; const int kend = q0 + 384 < 1024 ? q0 + 384 : 1024; ntl = (kend - kstart) >> 6; } else { kstart = 0; ntl = 16; } }
        else { const int uu = u - n_lat; b = uu / NH; h = uu % NH; q0 = 0; qrow0 = b * 256; ncache = 0; kstart = 0; ntl = 4; }
        const int kvh = h / GQ;
        const int krow0 = lat ? NCTX + b * 1024 : b * 256;
        const int nt = ncache + ntl;
        bf16x8 qf[DH / 16];
        { const bf16* qp = qn + (size_t)(qrow0 + wave * 32 + r32) * 1024 + h * DH + 8 * hi;
#pragma unroll
          for (int d0 = 0; d0 < DH / 16; ++d0) qf[d0] = *(const bf16x8*)(qp + 16 * d0); }
        float m, l;
        if (sink) { m = sink[h] * LOG2E; l = hi == 0 ? 1.f : 0.f; } else { m = -1e30f; l = 0.f; }
        f32x16 o[DH / 32];
#pragma unroll
        for (int db = 0; db < DH / 32; ++db)
#pragma unroll
            for (int r = 0; r < 16; ++r) o[db][r] = 0.f;
        const int qpos = q0 + wave * 32 + r32;
        u32x4 kreg[NLD], vreg[NLD];
        auto issue = [&](int t) {
            const bf16 *kp, *vp; size_t kpitch, vpitch;
            if (t < ncache) { kp = cK + ((size_t)(b * 512 + 64 * t) * NKV + kvh) * DH; vp = cV + ((size_t)(b * 512 + 64 * t) * NKV + kvh) * DH; kpitch = KW; vpitch = KW; }
            else { const int ks = kstart + 64 * (t - ncache); kp = kn + (size_t)(krow0 + ks) * KW + kvh * DH; vp = qkv + (size_t)(krow0 + ks) * ldq + 1024 + KW + kvh * DH; kpitch = KW; vpitch = ldq; }
#pragma unroll
            for (int i = 0; i < NLD; ++i) { const int c = tid + 512 * i, row = c / CPR, cc = c % CPR;
                kreg[i] = *(const u32x4*)(kp + (size_t)row * kpitch + cc * 8); vreg[i] = *(const u32x4*)(vp + (size_t)row * vpitch + cc * 8); }
        };
        issue(0);
        for (int t = 0; t < nt; ++t) {
            __syncthreads();
#pragma unroll
            for (int i = 0; i < NLD; ++i) { const int c = tid + 512 * i, row = c / CPR, cc = c % CPR;
                *(LAS u32x4*)(Ks + row * KSTR + cc * 16) = kreg[i]; *(LAS u32x4*)(Vs + row * KSTR + cc * 16) = vreg[i]; }
            __syncthreads();
            if (t + 1 < nt) issue(t + 1);
            const int kt0 = t < ncache ? -100000 : kstart + 64 * (t - ncache);
            bool active = true;
            if (WIN && lat && t >= ncache) { const int qw = q0 + wave * 32; if (kt0 + 63 < qw - 128 || kt0 > qw + 31 + 128) active = false; }
            if (active) {
                f32x16 p[2];
#pragma unroll
                for (int kh = 0; kh < 2; ++kh) {
#pragma unroll
                    for (int r = 0; r < 16; ++r) p[kh][r] = 0.f;
                    const LAS unsigned char* kb = Ks + (32 * kh + r32) * KSTR + 16 * hi;
#pragma unroll
                    for (int d0 = 0; d0 < DH / 16; ++d0) { const bf16x8 kf = *(const LAS bf16x8*)(kb + 32 * d0); p[kh] = __builtin_amdgcn_mfma_f32_32x32x16_bf16(kf, qf[d0], p[kh], 0, 0, 0); }
                }
                if (WIN && lat && t >= ncache) {
#pragma unroll
                    for (int kh = 0; kh < 2; ++kh)
#pragma unroll
                        for (int r = 0; r < 16; ++r) { const int kpos = kt0 + 32 * kh + (r & 3) + 8 * (r >> 2) + 4 * hi; const int dd = qpos - kpos; if (dd > 128 || dd < -128) p[kh][r] = -1e30f; }
                }
                float mx = p[0][0];
#pragma unroll
                for (int r = 1; r < 16; ++r) mx = fmaxf(mx, p[0][r]);
#pragma unroll
                for (int r = 0; r < 16; ++r) mx = fmaxf(mx, p[1][r]);
                mx = fmaxf(mx, shfl_xor_l(mx, 32, lane));
                const float mn = fmaxf(m, mx), sc = __builtin_amdgcn_exp2f(m - mn); m = mn;
                float ls = 0.f;
#pragma unroll
                for (int kh = 0; kh < 2; ++kh)
#pragma unroll
                    for (int r = 0; r < 16; ++r) { const float e = __builtin_amdgcn_exp2f(p[kh][r] - mn); p[kh][r] = e; ls += e; }
                l = l * sc + ls;
#pragma unroll
                for (int db = 0; db < DH / 32; ++db)
#pragma unroll
                    for (int r = 0; r < 16; ++r) o[db][r] *= sc;
                const int i16 = lane & 15, qq = i16 >> 2, pp = i16 & 3, blk = (lane >> 4) & 1;
#pragma unroll
                for (int kh = 0; kh < 2; ++kh)
#pragma unroll
                    for (int s2 = 0; s2 < 2; ++s2) {
                        u32x4 pw; pw.x = pk2(p[kh][8 * s2 + 0], p[kh][8 * s2 + 1]); pw.y = pk2(p[kh][8 * s2 + 2], p[kh][8 * s2 + 3]); pw.z = pk2(p[kh][8 * s2 + 4], p[kh][8 * s2 + 5]); pw.w = pk2(p[kh][8 * s2 + 6], p[kh][8 * s2 + 7]);
                        const bf16x8 pf = __builtin_bit_cast(bf16x8, pw);
                        const LAS unsigned char* vb = Vs + (32 * kh + 16 * s2 + 4 * hi + qq) * KSTR + 32 * blk + 8 * pp;
#pragma unroll
                        for (int db = 0; db < DH / 32; ++db) {
                            const s16x4 lo = __builtin_bit_cast(s16x4, __builtin_amdgcn_ds_read_tr16_b64_v4i16((LAS s16x4*)(vb + 64 * db)));
                            const s16x4 hh = __builtin_bit_cast(s16x4, __builtin_amdgcn_ds_read_tr16_b64_v4i16((LAS s16x4*)(vb + 64 * db + 8 * KSTR)));
                            const bf16x8 vf = __builtin_shufflevector(lo, hh, 0, 1, 2, 3, 4, 5, 6, 7);
                            o[db] = __builtin_amdgcn_mfma_f32_32x32x16_bf16(vf, pf, o[db], 0, 0, 0);
                        }
                    }
            }
        }
        l += shfl_xor_l(l, 32, lane);
        const float rl = 1.0f / l;
        bf16* op = ob + (size_t)(qrow0 + wave * 32 + r32) * 1024 + h * DH + 4 * hi;
#pragma unroll
        for (int db = 0; db < DH / 32; ++db)
#pragma unroll
            for (int g4 = 0; g4 < 4; ++g4) { u32x2 w; w.x = pk2(o[db][4 * g4] * rl, o[db][4 * g4 + 1] * rl); w.y = pk2(o[db][4 * g4 + 2] * rl, o[db][4 * g4 + 3] * rl);
                *(u32x2*)(op + 32 * db + 8 * g4) = w; }
        __syncthreads();
    }
}

template <int MODE>
__device__ __forceinline__ void s5_chunk(const bf16x8 af, const f32x4 yin, const bf16x8 (&bfr)[8], const bf16x8 (&cfr)[4], const bf16x8 dfr, const float ar, const float ai, float& hr, float& hi_,
                                         const int dir, float* yo, bf16* go, LAS float* Bu, LAS bf16* Hs, const int lane, const int n16, const int kq) {
    constexpr int BU_STR = 132, H_STR = 136;
    f32x4 accs[8];
#pragma unroll
    for (int nt = 0; nt < 8; ++nt) { accs[nt] = (f32x4){0.f, 0.f, 0.f, 0.f}; accs[nt] = __builtin_amdgcn_mfma_f32_16x16x32_bf16(af, bfr[nt], accs[nt], 0, 0, 0); }
    asm volatile("s_nop 15\n\ts_nop 7" : "+v"(accs[0]), "+v"(accs[1]), "+v"(accs[2]), "+v"(accs[3]), "+v"(accs[4]), "+v"(accs[5]), "+v"(accs[6]), "+v"(accs[7]));
#pragma unroll
    for (int nt = 0; nt < 8; ++nt)
#pragma unroll
        for (int i = 0; i < 4; ++i) Bu[(4 * kq + i) * BU_STR + 16 * nt + n16] = accs[nt][i];
    asm volatile("s_waitcnt lgkmcnt(0)" ::: "memory"); __builtin_amdgcn_wave_barrier();
    LAS float* bp = Bu + (dir ? 15 * BU_STR : 0) + lane; const int bstep = dir ? -BU_STR : BU_STR;
    LAS bf16* hp = Hs + (dir ? 15 * H_STR : 0) + lane; const int hstep = dir ? -H_STR : H_STR;
#pragma unroll
    for (int st = 0; st < 16; ++st) {
        const float br = bp[st * bstep], bi = bp[st * bstep + 64];
        const float nr = ar * hr - ai * hi_ + br, ni = ar * hi_ + ai * hr + bi;
        hr = nr; hi_ = ni;
        if (MODE != 0) { hp[st * hstep] = f2bf(hr); hp[st * hstep + 64] = f2bf(hi_); }
    }
    if (MODE != 0) {
        asm volatile("s_waitcnt lgkmcnt(0)" ::: "memory"); __builtin_amdgcn_wave_barrier();
        f32x4 y = {0.f, 0.f, 0.f, 0.f};
        if (MODE == 2) y = yin;
#pragma unroll
        for (int ks = 0; ks < 4; ++ks) { const bf16x8 hf = *(const LAS bf16x8*)(Hs + n16 * H_STR + 32 * ks + 8 * kq); y = __builtin_amdgcn_mfma_f32_16x16x32_bf16(hf, cfr[ks], y, 0, 0, 0); }
        if (MODE == 1) {
            asm volatile("s_nop 15\n\ts_nop 7" : "+v"(y));
#pragma unroll
            for (int i = 0; i < 4; ++i) yo[(size_t)i * D] = y[i];
        } else {
            y = __builtin_amdgcn_mfma_f32_16x16x32_bf16(af, dfr, y, 0, 0, 0);
            asm volatile("s_nop 15\n\ts_nop 7" : "+v"(y));
#pragma unroll
            for (int i = 0; i < 4; ++i) go[(size_t)i * D] = f2bf(gelu_tanh(y[i]));
        }
    }
    asm volatile("s_waitcnt lgkmcnt(0)" ::: "memory"); __builtin_amdgcn_wave_barrier();
}
template <int MODE>
__device__ __forceinline__ void s5_entry(const bf16* xl, const size_t ol, const int seg, const int dir, float* ytmp, bf16* gact, const bf16x8 (&bfr)[8], const bf16x8 (&cfr)[4], const bf16x8 dfr,
                                         const float ar, const float ai, float& hr, float& hi_, LAS float* Bu, LAS bf16* Hs, const int lane, const int n16, const int kq) {
    const int segrow = seg * 256;
#pragma unroll 1
    for (int g4 = 0; g4 < 4; ++g4) {
        const int c4 = 4 * g4;
        u32x4 cur[4]; f32x4 ycur[4];
        if (MODE == 2) asm volatile("s_waitcnt vmcnt(0)" ::: "memory");
#pragma unroll
        for (int k = 0; k < 4; ++k) { const int ch = c4 + k; cur[k] = (u32x4){0u, 0u, 0u, 0u}; ycur[k] = (f32x4){0.f, 0.f, 0.f, 0.f};
            if (kq < 2) cur[k] = *(const u32x4*)(xl + (size_t)(segrow + (dir ? 15 - ch : ch) * 16) * D);
            if (MODE == 2) { const float* yp = ytmp + ol + (size_t)(segrow + (15 - ch) * 16) * D;
#pragma unroll
                for (int i = 0; i < 4; ++i) ycur[k][i] = yp[(size_t)i * D]; } }
        asm volatile("s_waitcnt vmcnt(0)" : "+v"(cur[0]), "+v"(cur[1]), "+v"(cur[2]), "+v"(cur[3]), "+v"(ycur[0]), "+v"(ycur[1]), "+v"(ycur[2]), "+v"(ycur[3]) :: "memory");
#pragma unroll
        for (int k = 0; k < 4; ++k) {
            const int ch = c4 + k;
            const bf16x8 af = __builtin_bit_cast(bf16x8, cur[k]);
            const size_t orow = ol + (size_t)(segrow + (dir ? 15 - ch : ch) * 16) * D;
            s5_chunk<MODE>(af, ycur[k], bfr, cfr, dfr, ar, ai, hr, hi_, dir, ytmp + orow, gact + orow, Bu, Hs, lane, n16, kq);
        }
    }
    asm volatile("s_waitcnt vmcnt(0)" ::: "memory");
}
__device__ __forceinline__ void s5_phase(const Args& a, LAS unsigned char* lds, int wave, int lane) {
    constexpr int BU_STR = 132, WBYTES = 13056;
    LAS float* Bu = (LAS float*)(lds + wave * WBYTES);
    LAS bf16* Hs = (LAS bf16*)(lds + wave * WBYTES + 16 * BU_STR * 4);
    unsigned char* ws = (unsigned char*)inp(a, 44);
    const bf16* xn = (const bf16*)(ws + WS_XN);
    float* ytmp = (float*)(ws + WS_YTMP);
    bf16* gact = (bf16*)(ws + WS_GACT);
    const float *lam_re = inp(a, 25), *lam_im = inp(a, 26), *log_dt = inp(a, 27), *b_re = inp(a, 28), *b_im = inp(a, 29), *c_re = inp(a, 30), *c_im = inp(a, 31), *dskip = inp(a, 32);
    float* st_out = (float*)inp(a, 43) + 2 * (size_t)NCTX * D + 2 * 2097152;
    const int G = gridDim.x, gw = wave * G + blockIdx.x, NW = 8 * G;
    const int n16 = lane & 15, kq = lane >> 4;
    for (int u = gw; u < 4096; u += NW) {
        const bool lat = u < 2048;
        const int g = u & 63;
        const int seq = lat ? (u >> 8) : ((u - 2048) >> 6), sg = lat ? ((u >> 6) & 3) : 0;
        const int row0 = lat ? NCTX + seq * 1024 : seq * 256;
        const int ne = lat ? 5 : 2, total = ne * 16;
        const bf16* xl = xn + (size_t)(row0 + n16) * D + 16 * g + 8 * kq;
        const size_t ol = (size_t)(row0 + 4 * kq) * D + 16 * g + n16;
        bf16x8 dfr;
        { const float dv = dskip[16 * g + n16]; u32x4 w = {0u, 0u, 0u, 0u};
          if (kq < 2) { float v[8];
#pragma unroll
              for (int i = 0; i < 8; ++i) v[i] = (8 * kq + i == n16) ? dv : 0.f;
              w.x = pk2(v[0], v[1]); w.y = pk2(v[2], v[3]); w.z = pk2(v[4], v[5]); w.w = pk2(v[6], v[7]); }
          dfr = __builtin_bit_cast(bf16x8, w); }
        auto e_dir = [&](int e) -> int { return lat ? (e > sg ? 1 : 0) : e; };
        auto e_mode = [&](int e) -> int { return lat ? (e == sg ? 1 : (e == 4 ? 2 : 0)) : e + 1; };
        auto e_seg = [&](int e) -> int { return lat ? (e < sg ? e : ((e == sg || e == 4) ? sg : 4 + sg - e)) : 0; };
        auto chunk_row = [&](int c) -> int { const int e = c >> 4, ch = c & 15; return e_seg(e) * 256 + (e_dir(e) ? 15 - ch : ch) * 16; };
        bf16x8 bfr[8], cfr[4]; float ar = 0.f, ai = 0.f, hr = 0.f, hi_ = 0.f;
        int cur_dir = -1;
#pragma unroll 1
        for (int e = 0; e < ne; ++e) {
            const int dir = e_dir(e), mode = e_mode(e), seg = e_seg(e);
            if (dir != cur_dir) {
                cur_dir = dir;
                const int gb = dir * 64 + g;
                const float dt = __expf(log_dt[gb]);
                { const float lr = lam_re[gb * 64 + lane], li = lam_im[gb * 64 + lane]; const float mag = __expf(lr * dt); ar = mag * fast_cos(li * dt); ai = mag * fast_sin(li * dt); }
#pragma unroll
                for (int nt = 0; nt < 8; ++nt) {
                    const int j = 16 * nt + n16, pp = j & 63; const bool im = j >= 64;
                    const float lr = lam_re[gb * 64 + pp], li = lam_im[gb * 64 + pp]; const float mag = __expf(lr * dt);
                    const float are = mag * fast_cos(li * dt), aim = mag * fast_sin(li * dt), den = lr * lr + li * li, nre = are - 1.0f;
                    const float fre = (nre * lr + aim * li) / den, fim = (aim * lr - nre * li) / den;
                    u32x4 w = {0u, 0u, 0u, 0u};
                    if (kq < 2) {
                        const float* br = b_re + ((size_t)gb * 64 + pp) * 16 + 8 * kq; const float* bi = b_im + ((size_t)gb * 64 + pp) * 16 + 8 * kq;
                        float v[8];
#pragma unroll
                        for (int i = 0; i < 8; ++i) v[i] = im ? (fre * bi[i] + fim * br[i]) : (fre * br[i] - fim * bi[i]);
                        w.x = pk2(v[0], v[1]); w.y = pk2(v[2], v[3]); w.z = pk2(v[4], v[5]); w.w = pk2(v[6], v[7]);
                    }
                    bfr[nt] = __builtin_bit_cast(bf16x8, w);
                }
#pragma unroll
                for (int ks = 0; ks < 4; ++ks) {
                    const int k0 = 32 * ks + 8 * kq;
                    float v[8];
#pragma unroll
                    for (int i = 0; i < 8; ++i) { const int k = k0 + i; v[i] = k < 64 ? c_re[((size_t)gb * 16 + n16) * 64 + k] : -c_im[((size_t)gb * 16 + n16) * 64 + (k - 64)]; }
                    u32x4 w; w.x = pk2(v[0], v[1]); w.y = pk2(v[2], v[3]); w.z = pk2(v[4], v[5]); w.w = pk2(v[6], v[7]);
                    cfr[ks] = __builtin_bit_cast(bf16x8, w);
                }
                hr = 0.f; hi_ = 0.f;
                if (lat) { const float* s0 = inp(a, 4) + ((size_t)(seq * 2 + dir) * 2) * 4096 + g * 64 + lane; hr = s0[0]; hi_ = s0[4096]; }
            }
            if (mode == 0) s5_entry<0>(xl, ol, seg, dir, ytmp, gact, bfr, cfr, dfr, ar, ai, hr, hi_, Bu, Hs, lane, n16, kq);
            else if (mode == 1) s5_entry<1>(xl, ol, seg, dir, ytmp, gact, bfr, cfr, dfr, ar, ai, hr, hi_, Bu, Hs, lane, n16, kq);
            else s5_entry<2>(xl, ol, seg, dir, ytmp, gact, bfr, cfr, dfr, ar, ai, hr, hi_, Bu, Hs, lane, n16, kq);
            if (!lat) { float* so = st_out + ((size_t)(seq * 2 + dir) * 2) * 4096 + g * 64 + lane; so[0] = hr; so[4096] = hi_; }
        }
    }
}

__device__ __forceinline__ void conv_phase(const bf16* h, const float* ck, const float* cb, bf16* abuf, int tid) {
    const size_t NT = (size_t)gridDim.x * 512;
    for (size_t task = (size_t)blockIdx.x * 512 + tid; task < (size_t)352 * 1024; task += NT) {
        const int cgp = (int)(task % 352), rc = (int)(task / 352);
        const int j0 = cgp * 8, pn = j0 >> 7, jj = j0 & 127, hcol = 256 * pn + jj;
        const int r0 = rc * 16, L = r0 < NCTX ? 256 : 1024;
        const bool pv = (r0 % L) != 0, nv = ((r0 + 16) % L) != 0;
        float k0g[8], k1g[8], k2g[8], bg[8], k0v[8], k1v[8], k2v[8], bv[8];
#pragma unroll
        for (int e = 0; e < 8; ++e) { k0g[e] = ck[j0 + e]; k1g[e] = ck[FF2 + j0 + e]; k2g[e] = ck[2 * FF2 + j0 + e]; bg[e] = cb[j0 + e];
            k0v[e] = ck[FF + j0 + e]; k1v[e] = ck[FF2 + FF + j0 + e]; k2v[e] = ck[2 * FF2 + FF + j0 + e]; bv[e] = cb[FF + j0 + e]; }
        const bf16* hp = h + (size_t)r0 * FF2 + hcol;
        const u32x4 z = {0u, 0u, 0u, 0u};
        u32x4 gp = pv ? *(const u32x4*)(hp - FF2) : z, vp = pv ? *(const u32x4*)(hp - FF2 + 128) : z;
        u32x4 gc = *(const u32x4*)(hp), vc = *(const u32x4*)(hp + 128);
#pragma unroll 4
        for (int i = 0; i < 16; ++i) {
            const bool has = (i < 15) || nv;
            const u32x4 gn = has ? *(const u32x4*)(hp + (size_t)(i + 1) * FF2) : z, vn = has ? *(const u32x4*)(hp + (size_t)(i + 1) * FF2 + 128) : z;
            float o[8];
#pragma unroll
            for (int e = 0; e < 8; ++e) {
                const float a0 = __uint_as_float((e & 1) ? (gp[e >> 1] & 0xffff0000u) : (gp[e >> 1] << 16));
                const float a1 = __uint_as_float((e & 1) ? (gc[e >> 1] & 0xffff0000u) : (gc[e >> 1] << 16));
                const float a2 = __uint_as_float((e & 1) ? (gn[e >> 1] & 0xffff0000u) : (gn[e >> 1] << 16));
                const float b0 = __uint_as_float((e & 1) ? (vp[e >> 1] & 0xffff0000u) : (vp[e >> 1] << 16));
                const float b1 = __uint_as_float((e & 1) ? (vc[e >> 1] & 0xffff0000u) : (vc[e >> 1] << 16));
                const float b2 = __uint_as_float((e & 1) ? (vn[e >> 1] & 0xffff0000u) : (vn[e >> 1] << 16));
                const float gt = bg[e] + k0g[e] * a0 + k1g[e] * a1 + k2g[e] * a2;
                const float vl = bv[e] + k0v[e] * b0 + k1v[e] * b1 + k2v[e] * b2;
                o[e] = silu_f(gt) * vl;
            }
            u32x4 w; w.x = pk2(o[0], o[1]); w.y = pk2(o[2], o[3]); w.z = pk2(o[4], o[5]); w.w = pk2(o[6], o[7]);
            *(u32x4*)(abuf + (size_t)(r0 + i) * FF + j0) = w;
            gp = gc; vp = vc; gc = gn; vc = vn;
        }
    }
}

#define XB_TMO      128
#define XB_XCNT(j)  (256  + 64 * (j))
#define XB_XSUB(j)  (1280 + 64 * (j))
#define XB_XGEN(j)  (2304 + 64 * (j))
#define XB_TOP      3328
#define XB_TOPGEN   3392
#define XCD_BAR_WORDS 3456
#define XB_SPIN_CAP (1u << 18)

__device__ __forceinline__ unsigned xb_ld(unsigned* p)              { return __hip_atomic_load(p, __ATOMIC_RELAXED, __HIP_MEMORY_SCOPE_AGENT); }
__device__ __forceinline__ unsigned xb_add(unsigned* p, unsigned v) { return __hip_atomic_fetch_add(p, v, __ATOMIC_RELAXED, __HIP_MEMORY_SCOPE_AGENT); }
__device__ __forceinline__ unsigned xb_xcc_id() { return (unsigned)__builtin_amdgcn_s_getreg((3 << 11) | 20) & 0xFu; }
#define XB_SPIN(cond, bar) do { unsigned _sp = 0; while (cond) { __builtin_amdgcn_s_sleep(1); \
    if ((++_sp & 255u) == 0u) { if (xb_ld(&(bar)[XB_TMO])) break; if (_sp > XB_SPIN_CAP) { atomicAdd(&(bar)[XB_TMO], 1u); break; } } } } while (0)

struct XcdBarrier {
    unsigned* bar; unsigned x;
    volatile LAS unsigned* st;
};

__device__ __forceinline__ XcdBarrier xcd_barrier_post(unsigned* bar, volatile LAS unsigned* st) {
    XcdBarrier b; b.bar = bar; b.x = xb_xcc_id(); b.st = st;
    if (threadIdx.x == 0) (void)xb_add(&bar[XB_XCNT(b.x)], 1u);
    return b;
}
__device__ __forceinline__ void xcd_barrier_complete(unsigned* bar, unsigned x, unsigned& nloc, unsigned& nx) {
    const unsigned G = gridDim.x * gridDim.y * gridDim.z;
    unsigned sum, cnt, mine, sp = 0u;
    for (;;) {
        sum = 0u; cnt = 0u; mine = 0u;
#pragma unroll
        for (unsigned j = 0; j < 16; ++j) { const unsigned c = xb_ld(&bar[XB_XCNT(j)]); sum += c; cnt += (c > 0u) ? 1u : 0u; mine = (j == x) ? c : mine; }
        if (sum == G) break;
        __builtin_amdgcn_s_sleep(1);
        if ((++sp & 255u) == 0u) { if (xb_ld(&bar[XB_TMO])) break; if (sp > XB_SPIN_CAP) { atomicAdd(&bar[XB_TMO], 1u); break; } }
    }
    nloc = mine > 0u ? mine : 1u; nx = cnt > 0u ? cnt : 1u;
}

__device__ __forceinline__ void xcd_barrier(const XcdBarrier& b) {
    asm volatile("s_waitcnt vmcnt(0)" ::: "memory");
    __syncthreads();
    if (threadIdx.x == 0) {
        unsigned* bar = b.bar;
        __builtin_amdgcn_s_waitcnt(0);
        unsigned nloc = b.st[0], nx = b.st[1];
        if (nloc == 0u) { xcd_barrier_complete(bar, b.x, nloc, nx); b.st[0] = nloc; b.st[1] = nx; }
        const unsigned old = xb_add(&bar[XB_XSUB(b.x)], 1u);
        const unsigned gen = old / nloc;
        if (old + 1u == (gen + 1u) * nloc) {
            __builtin_amdgcn_fence(__ATOMIC_RELEASE, "agent");
            asm volatile("s_waitcnt vmcnt(0)" ::: "memory");
            const unsigned og = xb_add(&bar[XB_TOP], 1u);
            const unsigned tg = og / nx;
            if (og + 1u == (tg + 1u) * nx) xb_add(&bar[XB_TOPGEN], 1u);
            else XB_SPIN(xb_ld(&bar[XB_TOPGEN]) == tg, bar);
            __builtin_amdgcn_fence(__ATOMIC_ACQUIRE, "agent");
            xb_add(&bar[XB_XGEN(b.x)], 1u);
            asm volatile("s_waitcnt vmcnt(0)" ::: "memory");
        } else {
            XB_SPIN(xb_ld(&bar[XB_XGEN(b.x)]) == gen, bar);
            __builtin_amdgcn_fence(__ATOMIC_ACQUIRE, "agent");
            asm volatile("s_waitcnt vmcnt(0)" ::: "memory");
        }
    }
    __syncthreads();
}

constexpr int LDS_BYTES = 147456;
constexpr int NPHASE = 37;
__global__ void __launch_bounds__(512, 2) hybrid_fwd(Args a) {
    extern __shared__ __attribute__((aligned(16))) unsigned char lds_raw[];
    LAS unsigned char* lds = (LAS unsigned char*)lds_raw;
    cg::grid_group grid = cg::this_grid();
    if (a.ph_lo < 0) grid.sync();
    { volatile LAS unsigned* m = (volatile LAS unsigned*)(lds + 131072); if (threadIdx.x < 16) m[threadIdx.x] = 0u; }
    __syncthreads();
    XcdBarrier bar = xcd_barrier_post((unsigned*)inp(a, 44), (volatile LAS unsigned*)(lds + 131072) + 8);
    bool first = true;
    for (int idx = a.ph_lo; idx < a.ph_hi; ++idx) {
        int ph = idx;
        if (PROBE_DUP >= 0 && idx > PROBE_DUP) ph = idx - 1;
        int tid = threadIdx.x; asm volatile("" : "+v"(tid));
        const int lane = tid & 63, wave = __builtin_amdgcn_readfirstlane(tid >> 6);
        unsigned char* ws = (unsigned char*)inp(a, 44);
        float* x = (float*)inp(a, 43);
        bf16* xn = (bf16*)(ws + WS_XN);
        const int l = (ph - 1) / 9, sub = (ph - 1) % 9;
        if (ph > 0 && l == 1 && (sub == 3 || sub == 4)) continue;
        if (!first) xcd_barrier(bar);
        first = false;
        #ifndef NO_PRO
        if (ph == 0) { prologue_phase(a, lds, tid, wave, lane); continue; }
#endif
        const float* mod = (const float*)(ws + WS_MOD) + (size_t)l * 9 * 6144;
        const int kind = (l == 1) ? 1 : (l == 2 ? 2 : 0);
        const int nqkv = kind == 2 ? 2048 : 1536;
        bf16* qkv = (bf16*)(ws + WS_QKV); bf16* qn = (bf16*)(ws + WS_QN); bf16* kn = (bf16*)(ws + WS_KN); bf16* ob = (bf16*)(ws + WS_OB);
#ifndef NO_NORM
        if (sub == 0) { norm_phase(x, inp(a, 11) + l * D, mod, 0, 1024, xn, wave, lane); continue; }
        if (sub == 5) { norm_phase(x, inp(a, 12) + l * D, mod, 3072, 4096, xn, wave, lane); continue; }
#endif
#ifndef NO_GEMM
        {
            const bool isg = (sub == 1 && kind != 1) || sub == 6 || (sub == 4 && kind != 1) || sub == 8 || (sub == 2 && kind == 1);
            if (isg) {
                pg8::Gemm g; pg8::EpiMulti E;
                E.e0 = pg8::EpiBf16<0>{qkv, nqkv, nullptr, 0, 0, 1.f}; E.e1 = pg8::EpiResGate{x, mod, 2048}; E.e2 = pg8::EpiGlu{x, mod, 2048};
                if (sub == 1) { const bf16* wt = (const bf16*)(ws + (l == 0 ? WS_WQKV0 : (l == 2 ? WS_WQKV2 : WS_WQKV3))); g = pg8::Gemm{xn, wt, MROWS, nqkv, D}; E.mode = 0; }
                else if (sub == 6) { g = pg8::Gemm{xn, (const bf16*)(ws + WS_WUP) + (size_t)l * FF2 * 1024, MROWS, FF2, D}; E.mode = 0;
                    E.e0 = pg8::EpiBf16<0>{(bf16*)(ws + WS_H), FF2, (const float*)(ws + WS_BUPP) + l * FF2, 0, 0, 1.f}; }
                else if (sub == 4) { const bf16* wt = (const bf16*)(ws + (l == 0 ? WS_WO0 : (l == 2 ? WS_WO2 : WS_WO3))); g = pg8::Gemm{ob, wt, MROWS, D, D}; E.mode = 1; }
                else if (sub == 8) { g = pg8::Gemm{(const bf16*)(ws + WS_ABUF), (const bf16*)(ws + WS_WDN) + (size_t)l * 1024 * FF, MROWS, D, FF}; E.mode = 1; E.e1.goff = 5120; }
                else { g = pg8::Gemm{(const bf16*)(ws + WS_GACT), (const bf16*)(ws + WS_WGLU), MROWS, 2048, D}; E.mode = 2; }
                pg8::StaticOrder S; S.init(g.M, g.N, gridDim.x, (int)blockIdx.x);
                pg8::gemm_phase<pg8::EpiMulti, pg8::StaticOrder, true, true>(lds, g, S, E, tid);
                continue;
            }
        }
#endif
#ifndef NO_CONV
        if (sub == 7) { conv_phase((const bf16*)(ws + WS_H), inp(a, 17) + (size_t)l * 3 * FF2, inp(a, 18) + (size_t)l * FF2, (bf16*)(ws + WS_ABUF), tid); continue; }
#endif
        if (kind == 1) {
#ifndef NO_S5
            if (sub == 1) { s5_phase(a, lds, wave, lane); continue; }
#endif
            continue;
        }
        float* o_k = x + 2 * (size_t)NCTX * D + (l == 0 ? 0 : (l == 2 ? 2 * 2097152 + 524288 : 2 * 2097152 + 524288 + 2 * 4194304));
#ifndef NO_QKP
        if (sub == 2) {
            if (kind == 0) qkprep_phase<64>(qkv, 4, inp(a, l == 0 ? 21 : 39), inp(a, l == 0 ? 22 : 40), qn, kn, o_k, o_k + 2097152, wave, lane);
            else qkprep_phase<128>(qkv, 4, inp(a, 35), inp(a, 36), qn, kn, o_k, o_k + 4194304, wave, lane);
            continue;
        }
#endif
#ifndef NO_ATT
        if (sub == 3) {
            if (kind == 0) attn_phase<64, true>(qn, kn, qkv, (const bf16*)(ws + (l == 0 ? WS_C0K : WS_C3K)), (const bf16*)(ws + (l == 0 ? WS_C0V : WS_C3V)), inp(a, l == 0 ? 23 : 41), ob, lds, tid, wave, lane);
            else attn_phase<128, false>(qn, kn, qkv, (const bf16*)(ws + WS_C2K), (const bf16*)(ws + WS_C2V), nullptr, ob, lds, tid, wave, lane);
            continue;
        }
#endif
    }
}

extern "C" void kernel_launch(void* const* d_in, const int* in_sizes, int n_in, void* d_out, int out_size, void* d_ws, size_t ws_size, hipStream_t stream) {
    static int grid = 0;
    if (grid == 0) {
        if (n_in != 43 || ws_size < WS_END) { fprintf(stderr, "kernel_launch: unexpected n_in %d / ws_size %zu (need %zu)\n", n_in, ws_size, (size_t)WS_END); grid = -1; return; }
        int dev = 0, cus = 0, per_cu = 0;
        hipGetDevice(&dev);
        hipDeviceGetAttribute(&cus, hipDeviceAttributeMultiprocessorCount, dev);
        hipFuncSetAttribute((const void*)hybrid_fwd, hipFuncAttributeMaxDynamicSharedMemorySize, LDS_BYTES);
        hipOccupancyMaxActiveBlocksPerMultiprocessor(&per_cu, (const void*)hybrid_fwd, 512, LDS_BYTES);
        if (per_cu < 1) per_cu = 1;
        (void)hipGetLastError();
        grid = cus * per_cu;
        if (grid > 256) grid = 256;
    }
    if (grid < 0) return;
    if (hipMemsetAsync(d_ws, 0, 65536, stream) != hipSuccess) { fprintf(stderr, "kernel_launch: memset failed\n"); return; }
    Args a{};
    for (int i = 0; i < 43; ++i) a.in[i] = (const float*)d_in[i];
    a.in[43] = (const float*)d_out; a.in[44] = (const float*)d_ws;
#if ONE_LAUNCH
    a.ph_lo = 0; a.ph_hi = NPHASE + (PROBE_DUP >= 0 ? 1 : 0);
    void* kargs[] = {&a};
    hipError_t e = hipLaunchCooperativeKernel((const void*)hybrid_fwd, dim3(grid), dim3(512), kargs, LDS_BYTES, stream);
    if (e != hipSuccess) fprintf(stderr, "cooperative launch failed: %s (grid %d)\n", hipGetErrorString(e), grid);
#else
    for (int ph = 0; ph < NPHASE; ++ph) {
        const int l = (ph - 1) / 9, sub = (ph - 1) % 9;
        if (ph > 0 && l == 1 && (sub == 3 || sub == 4)) continue;
        a.ph_lo = ph; a.ph_hi = ph + 1;
        hipLaunchKernelGGL(hybrid_fwd, dim3(grid), dim3(512), LDS_BYTES, stream, a);
    }
#endif
}
```
